# Optimizing an MI355X kernel written in HIP

```python
import math
import jax
import jax.numpy as jnp
from jax import lax
import numpy as np


D_MODEL = 1024
BATCH = 1
SEQ = 16384
DEPTH = 2

GRID_W = 64
CTX_LEN = 256
EPS = 1e-6
NEG = -1e30
Q_BLOCK = 128
ROPE_DIM = 64
ROPE_THETA = 10000.0

A_HEADS = 8
A_KV_HEADS = 2
A_HEAD_DIM = ROPE_DIM
A_WINDOW = 128
B_HEADS = 4
B_HEAD_DIM = ROPE_DIM
C_HEADS = 4
C_Q_RANK = 256
C_KV_RANK = 128
C_NOPE_DIM = 128
C_ROPE_DIM = ROPE_DIM
C_V_DIM = 128
D_HEADS = 8
D_HEAD_DIM = 64
D_WIN_ROWS = 8
D_WIN_COLS = 16

MIX_EVEN = A_HEADS * A_HEAD_DIM + B_HEADS * 2 * B_HEAD_DIM
MIX_ODD = C_HEADS * C_V_DIM + D_HEADS * D_HEAD_DIM
EVEN_SPLITS = (A_HEADS * A_HEAD_DIM, A_KV_HEADS * A_HEAD_DIM, A_KV_HEADS * A_HEAD_DIM, B_HEADS * 2 * B_HEAD_DIM, B_HEADS * 2 * B_HEAD_DIM, B_HEADS * 2 * B_HEAD_DIM, MIX_EVEN)
ODD_SPLITS = (C_Q_RANK, C_KV_RANK, C_ROPE_DIM, D_HEADS * D_HEAD_DIM, D_HEADS * D_HEAD_DIM, D_HEADS * D_HEAD_DIM, MIX_ODD)
IN_EVEN = sum(EVEN_SPLITS)
IN_ODD = sum(ODD_SPLITS)

kernel_name = 'hybrid_dit_window_diff_mla_natten'


def rmsnorm(x, g):
    xf = x.astype(jnp.float32)
    y = xf * lax.rsqrt(jnp.mean(xf * xf, axis=-1, keepdims=True) + EPS)
    return (y * g.astype(jnp.float32)).astype(x.dtype)


def _split(t, sizes):
    return jnp.split(t, np.cumsum(sizes)[:-1].tolist(), axis=-1)


def _axial_rope_tables(S, dim):
    t = jnp.arange(S)
    row = (t // GRID_W).astype(jnp.float32)
    col = (t % GRID_W).astype(jnp.float32)
    quarter = dim // 4
    inv = ROPE_THETA ** (-jnp.arange(quarter, dtype=jnp.float32) / quarter)
    ang_r = row[:, None] * inv[None, :]
    ang_c = col[:, None] * inv[None, :]
    ang = jnp.concatenate([ang_r, ang_r, ang_c, ang_c], axis=-1)
    return jnp.cos(ang), jnp.sin(ang)


def _rope(x, cos, sin):
    half = x.shape[-1] // 2
    qtr = half // 2
    xr, xc = x[..., :half], x[..., half:]
    rot = jnp.concatenate([-xr[..., qtr:], xr[..., :qtr], -xc[..., qtr:], xc[..., :qtr]], axis=-1)
    return (x * cos[:, None, :] + rot * sin[:, None, :]).astype(x.dtype)


def _modulate(x, cond, norm_g, w_ada, b_ada):
    mod = jax.nn.silu(cond) @ w_ada + b_ada
    shift, scale, gate = jnp.split(mod[:, None, :], 3, axis=-1)
    return rmsnorm(x, norm_g) * (1.0 + scale) + shift, gate


def _sweep_query_blocks(fn, q):
    B, S = q.shape[:2]
    nb = S // Q_BLOCK
    qb = jnp.moveaxis(q.reshape((B, nb, Q_BLOCK) + q.shape[2:]), 1, 0)
    out = lax.map(lambda a: fn(a[0], a[1]), (jnp.arange(nb), qb))
    out = jnp.moveaxis(out, 0, 1)
    return out.reshape((B, S) + out.shape[3:])


def _softmax_attend(q, k, v):
    s = jnp.einsum('bqhd,bkhd->bhqk', q, k).astype(jnp.float32) * (q.shape[-1] ** -0.5)
    p = jax.nn.softmax(s, axis=-1).astype(v.dtype)
    return jnp.einsum('bhqk,bkhe->bqhe', p, v)


def _sink_probs(parts, sink):
    base = parts[0]
    Hk, G = base.shape[1], base.shape[2]
    snk = jnp.broadcast_to(sink.astype(jnp.float32).reshape(Hk, G)[None, :, :, None, None], base.shape[:-1] + (1,))
    p = jax.nn.softmax(jnp.concatenate(list(parts) + [snk], axis=-1), axis=-1)
    return p[..., :-1]


def _window_gqa_sink(q, k, v, kc, vc, sink):
    B, S, Hk, G, d = q.shape
    L = kc.shape[1]
    W = A_WINDOW
    span = Q_BLOCK + 2 * W
    scale = d ** -0.5
    kp = jnp.pad(k, ((0, 0), (W, W), (0, 0), (0, 0)))
    vp = jnp.pad(v, ((0, 0), (W, W), (0, 0), (0, 0)))

    def block(n, qn):
        start = n * Q_BLOCK
        kn = lax.dynamic_slice_in_dim(kp, start, span, axis=1)
        vn = lax.dynamic_slice_in_dim(vp, start, span, axis=1)
        qpos = start + jnp.arange(Q_BLOCK)
        kpos = start - W + jnp.arange(span)
        valid = (jnp.abs(qpos[:, None] - kpos[None, :]) <= W) & (kpos >= 0)[None, :] & (kpos < S)[None, :]
        s_loc = jnp.einsum('bqkgd,bskd->bkgqs', qn, kn).astype(jnp.float32) * scale
        s_loc = jnp.where(valid, s_loc, NEG)
        s_ctx = jnp.einsum('bqkgd,bckd->bkgqc', qn, kc).astype(jnp.float32) * scale
        p = _sink_probs([s_loc, s_ctx], sink).astype(v.dtype)
        return (jnp.einsum('bkgqs,bskd->bqkgd', p[..., :span], vn)
                + jnp.einsum('bkgqc,bckd->bqkgd', p[..., span:span + L], vc))

    return _sweep_query_blocks(block, q)


def _ctx_sink_attend(q, k, v, sink):
    s = jnp.einsum('bqkgd,bckd->bkgqc', q, k).astype(jnp.float32) * (q.shape[-1] ** -0.5)
    p = _sink_probs([s], sink).astype(v.dtype)
    return jnp.einsum('bkgqc,bckd->bqkgd', p, v)


def _diff_lambda(b_lambda, lam_init):
    lf = b_lambda.astype(jnp.float32)
    return jnp.exp(jnp.sum(lf[0] * lf[1])) - jnp.exp(jnp.sum(lf[2] * lf[3])) + lam_init


def _diff_attend(q, k, v, lam):
    s = jnp.einsum('bqhte,bkhte->bhtqk', q, k).astype(jnp.float32) * (q.shape[-1] ** -0.5)
    p = jax.nn.softmax(s, axis=-1)
    a = (p[:, :, 0] - lam * p[:, :, 1]).astype(v.dtype)
    return jnp.einsum('bhqk,bkhe->bqhe', a, v)


def _mla_qkv(cq, ckv, kr, q_norm_g, kv_norm_g, w_qb, w_kvb, cos, sin):
    B, T, _ = cq.shape
    q = (rmsnorm(cq, q_norm_g) @ w_qb).reshape(B, T, C_HEADS, C_NOPE_DIM + C_ROPE_DIM)
    kv = (rmsnorm(ckv, kv_norm_g) @ w_kvb).reshape(B, T, C_HEADS, C_NOPE_DIM + C_V_DIM)
    q_nope, q_pe = q[..., :C_NOPE_DIM], q[..., C_NOPE_DIM:]
    k_nope, v = kv[..., :C_NOPE_DIM], kv[..., C_NOPE_DIM:]
    k_pe = kr[:, :, None, :]
    if cos is not None:
        q_pe = _rope(q_pe, cos, sin)
        k_pe = _rope(k_pe, cos, sin)
    q = jnp.concatenate([q_nope, q_pe], axis=-1)
    k = jnp.concatenate([k_nope, jnp.broadcast_to(k_pe, (B, T, C_HEADS, C_ROPE_DIM))], axis=-1)
    return q, k, v


def _neighbourhood_attend(q, k, v, kc, vc, rpb):
    B, S, H, d = q.shape
    L = kc.shape[1]
    rows = S // GRID_W
    kr_n = min(D_WIN_ROWS, rows)
    kw_n = D_WIN_COLS
    n_loc = kr_n * GRID_W
    scale = d ** -0.5
    kg = k.reshape(B, rows, GRID_W, H, d)
    vg = v.reshape(B, rows, GRID_W, H, d)
    cols = jnp.arange(GRID_W)
    cs = jnp.clip(cols - kw_n // 2, 0, GRID_W - kw_n)
    col_ok = (cols[None, :] >= cs[:, None]) & (cols[None, :] < cs[:, None] + kw_n)
    mask = jnp.broadcast_to(col_ok[:, None, :], (GRID_W, kr_n, GRID_W)).reshape(GRID_W, n_loc)
    dc = jnp.clip(cols[None, :] - cols[:, None] + (D_WIN_COLS - 1), 0, 2 * D_WIN_COLS - 2)
    rpb_f = rpb.astype(jnp.float32)
    qg = jnp.moveaxis(q.reshape(B, rows, GRID_W, H, d), 1, 0)

    def row_fn(args):
        r, qr = args
        rs = jnp.clip(r - kr_n // 2, 0, rows - kr_n)
        ks = lax.dynamic_slice_in_dim(kg, rs, kr_n, axis=1).reshape(B, n_loc, H, d)
        vs = lax.dynamic_slice_in_dim(vg, rs, kr_n, axis=1).reshape(B, n_loc, H, d)
        dr = rs + jnp.arange(kr_n) - r + (D_WIN_ROWS - 1)
        bias = rpb_f[:, dr[:, None, None], dc[None, :, :]]
        bias = jnp.transpose(bias, (0, 2, 1, 3)).reshape(H, GRID_W, n_loc)
        s_loc = jnp.einsum('bqhd,bkhd->bhqk', qr, ks).astype(jnp.float32) * scale + bias[None]
        s_loc = jnp.where(mask, s_loc, NEG)
        s_ctx = jnp.einsum('bqhd,bchd->bhqc', qr, kc).astype(jnp.float32) * scale
        p = jax.nn.softmax(jnp.concatenate([s_loc, s_ctx], axis=-1), axis=-1).astype(v.dtype)
        return (jnp.einsum('bhqk,bkhd->bqhd', p[..., :n_loc], vs)
                + jnp.einsum('bhqc,bchd->bqhd', p[..., n_loc:], vc))

    out = lax.map(row_fn, (jnp.arange(rows), qg))
    return jnp.moveaxis(out, 0, 1).reshape(B, S, H, d)


def _even_layer(x, xc, c, c_ctx, li, norm_g, w_ada, b_ada, w_in, a_sink, b_lambda, b_subln_g, w_out, cos, sin, ctx_out):
    B, S, _ = x.shape
    L = xc.shape[1]
    d = A_HEAD_DIM
    e = B_HEAD_DIM
    Hk, G = A_KV_HEADS, A_HEADS // A_KV_HEADS
    h, gate = _modulate(x, c, norm_g, w_ada, b_ada)
    hc, gate_c = _modulate(xc, c_ctx[None, :], norm_g, w_ada, b_ada)
    qa, ka, va, qb, kb, vb, g = _split(h @ w_in, EVEN_SPLITS)
    qac, kac, vac, qbc, kbc, vbc, gc = _split(hc @ w_in, EVEN_SPLITS)
    qa = _rope(qa.reshape(B, S, A_HEADS, d), cos, sin).reshape(B, S, Hk, G, d)
    ka = _rope(ka.reshape(B, S, Hk, d), cos, sin)
    va = va.reshape(B, S, Hk, d)
    kac = kac.reshape(B, L, Hk, d)
    vac = vac.reshape(B, L, Hk, d)
    ya = _window_gqa_sink(qa, ka, va, kac, vac, a_sink)
    qb = _rope(qb.reshape(B, S, B_HEADS * 2, e), cos, sin).reshape(B, S, B_HEADS, 2, e)
    kb = _rope(kb.reshape(B, S, B_HEADS * 2, e), cos, sin).reshape(B, S, B_HEADS, 2, e)
    vb = vb.reshape(B, S, B_HEADS, 2 * e)
    kbc = kbc.reshape(B, L, B_HEADS, 2, e)
    vbc = vbc.reshape(B, L, B_HEADS, 2 * e)
    lam_init = 0.8 - 0.6 * math.exp(-0.3 * li)
    lam = _diff_lambda(b_lambda, lam_init)
    kb_all = jnp.concatenate([kb, kbc], axis=1)
    vb_all = jnp.concatenate([vb, vbc], axis=1)
    yb = _sweep_query_blocks(lambda n, qn: _diff_attend(qn, kb_all, vb_all, lam), qb)
    yb = rmsnorm(yb, b_subln_g) * (1.0 - lam_init)
    y = jnp.concatenate([ya.reshape(B, S, -1), yb.reshape(B, S, -1)], axis=-1) * jax.nn.silu(g)
    x = x + gate * (y @ w_out)
    if ctx_out:
        yac = _ctx_sink_attend(qac.reshape(B, L, Hk, G, d), kac, vac, a_sink)
        ybc = rmsnorm(_diff_attend(qbc.reshape(B, L, B_HEADS, 2, e), kbc, vbc, lam), b_subln_g) * (1.0 - lam_init)
        yc = jnp.concatenate([yac.reshape(B, L, -1), ybc.reshape(B, L, -1)], axis=-1) * jax.nn.silu(gc)
        xc = xc + gate_c * (yc @ w_out)
    return x, xc


def _odd_layer(x, xc, c, c_ctx, norm_g, w_ada, b_ada, w_in, q_norm_g, kv_norm_g, w_qb, w_kvb, rpb, w_out, cos, sin, ctx_out):
    B, S, _ = x.shape
    L = xc.shape[1]
    dd = D_HEAD_DIM
    h, gate = _modulate(x, c, norm_g, w_ada, b_ada)
    hc, gate_c = _modulate(xc, c_ctx[None, :], norm_g, w_ada, b_ada)
    cq, ckv, kr, qd, kd, vd, g = _split(h @ w_in, ODD_SPLITS)
    cqc, ckvc, krc, qdc, kdc, vdc, gc = _split(hc @ w_in, ODD_SPLITS)
    qm, km, vm = _mla_qkv(cq, ckv, kr, q_norm_g, kv_norm_g, w_qb, w_kvb, cos, sin)
    qmc, kmc, vmc = _mla_qkv(cqc, ckvc, krc, q_norm_g, kv_norm_g, w_qb, w_kvb, None, None)
    km_all = jnp.concatenate([km, kmc], axis=1)
    vm_all = jnp.concatenate([vm, vmc], axis=1)
    ym = _sweep_query_blocks(lambda n, qn: _softmax_attend(qn, km_all, vm_all), qm)
    kdc = kdc.reshape(B, L, D_HEADS, dd)
    vdc = vdc.reshape(B, L, D_HEADS, dd)
    yd = _neighbourhood_attend(qd.reshape(B, S, D_HEADS, dd), kd.reshape(B, S, D_HEADS, dd), vd.reshape(B, S, D_HEADS, dd), kdc, vdc, rpb)
    y = jnp.concatenate([ym.reshape(B, S, -1), yd.reshape(B, S, -1)], axis=-1) * jax.nn.silu(g)
    x = x + gate * (y @ w_out)
    if ctx_out:
        ymc = _softmax_attend(qmc, kmc, vmc)
        ydc = _softmax_attend(qdc.reshape(B, L, D_HEADS, dd), kdc, vdc)
        yc = jnp.concatenate([ymc.reshape(B, L, -1), ydc.reshape(B, L, -1)], axis=-1) * jax.nn.silu(gc)
        xc = xc + gate_c * (yc @ w_out)
    return x, xc


def setup_inputs(seed: int = 0) -> dict:
    key = jax.random.key(seed)
    keys = iter(jax.random.split(key, 24))

    def nrm(shape, std):
        return std * jax.random.normal(next(keys), shape, jnp.float32)

    D = D_MODEL
    n_ev = (DEPTH + 1) // 2
    n_od = DEPTH // 2
    return {
        'x': nrm((BATCH, SEQ, D), 1.0),
        'c': nrm((BATCH, D), 1.0),
        'ctx': nrm((BATCH, CTX_LEN, D), 1.0),
        'c_ctx': nrm((D,), 1.0),
        'ev_norm_g': 1.0 + nrm((n_ev, D), 0.02),
        'ev_w_ada': nrm((n_ev, D, 3 * D), D ** -0.5),
        'ev_b_ada': nrm((n_ev, 3 * D), 0.02),
        'ev_w_in': nrm((n_ev, D, IN_EVEN), D ** -0.5),
        'ev_a_sink': nrm((n_ev, A_HEADS), 0.5),
        'ev_b_lambda': nrm((n_ev, 4, B_HEAD_DIM), 0.1),
        'ev_b_subln_g': 1.0 + nrm((n_ev, 2 * B_HEAD_DIM), 0.02),
        'ev_w_out': nrm((n_ev, MIX_EVEN, D), MIX_EVEN ** -0.5),
        'od_norm_g': 1.0 + nrm((n_od, D), 0.02),
        'od_w_ada': nrm((n_od, D, 3 * D), D ** -0.5),
        'od_b_ada': nrm((n_od, 3 * D), 0.02),
        'od_w_in': nrm((n_od, D, IN_ODD), D ** -0.5),
        'od_c_q_norm_g': 1.0 + nrm((n_od, C_Q_RANK), 0.02),
        'od_c_kv_norm_g': 1.0 + nrm((n_od, C_KV_RANK), 0.02),
        'od_c_w_qb': nrm((n_od, C_Q_RANK, C_HEADS * (C_NOPE_DIM + C_ROPE_DIM)), C_Q_RANK ** -0.5),
        'od_c_w_kvb': nrm((n_od, C_KV_RANK, C_HEADS * (C_NOPE_DIM + C_V_DIM)), C_KV_RANK ** -0.5),
        'od_d_rpb': nrm((n_od, D_HEADS, 2 * D_WIN_ROWS - 1, 2 * D_WIN_COLS - 1), 0.02),
        'od_w_out': nrm((n_od, MIX_ODD, D), MIX_ODD ** -0.5),
        'final_norm_g': 1.0 + nrm((D,), 0.02),
    }


def reference(x, c, ctx, c_ctx, ev_norm_g, ev_w_ada, ev_b_ada, ev_w_in, ev_a_sink, ev_b_lambda, ev_b_subln_g, ev_w_out, od_norm_g, od_w_ada, od_b_ada, od_w_in, od_c_q_norm_g, od_c_kv_norm_g, od_c_w_qb, od_c_w_kvb, od_d_rpb, od_w_out, final_norm_g):
    S = x.shape[1]
    cos, sin = _axial_rope_tables(S, ROPE_DIM)
    xl, xc = x, ctx
    for i in range(DEPTH):
        ctx_out = i < DEPTH - 1
        j = i // 2
        if i % 2 == 0:
            xl, xc = _even_layer(xl, xc, c, c_ctx, i, ev_norm_g[j], ev_w_ada[j], ev_b_ada[j], ev_w_in[j], ev_a_sink[j], ev_b_lambda[j], ev_b_subln_g[j], ev_w_out[j], cos, sin, ctx_out)
        else:
            xl, xc = _odd_layer(xl, xc, c, c_ctx, od_norm_g[j], od_w_ada[j], od_b_ada[j], od_w_in[j], od_c_q_norm_g[j], od_c_kv_norm_g[j], od_c_w_qb[j], od_c_w_kvb[j], od_d_rpb[j], od_w_out[j], cos, sin, ctx_out)
    return rmsnorm(xl, final_norm_g)
```

```cpp
#include <hip/hip_runtime.h>
#include <hip/hip_cooperative_groups.h>
#include <cstdio>
namespace cg = cooperative_groups;

typedef __bf16 hf;
using h8 = __attribute__((ext_vector_type(8))) __bf16;
using h4 = __attribute__((ext_vector_type(4))) __bf16;
using s16x8 = __attribute__((ext_vector_type(8))) short;
using f32x16 = __attribute__((ext_vector_type(16))) float;
using f32x4 = __attribute__((ext_vector_type(4))) float;
using u32x4 = __attribute__((ext_vector_type(4))) unsigned;
using s16x4 = __attribute__((ext_vector_type(4))) short;
#define DI __device__ __forceinline__

constexpr int S_LAT = 16384, M_ALL = 16640, DM = 1024;
constexpr int IN_E = 3328, IN_O = 3008, IN_OP = 3072;
constexpr int NTHR = 512;
constexpr float LOG2E = 1.4426950408889634f;
constexpr float NEGV = -1e30f;
constexpr float EPS = 1e-6f;
constexpr int LDS_BYTES = 131072;

struct Params {
  const float *x, *c, *ctx, *c_ctx, *ev_norm_g, *ev_w_ada, *ev_b_ada, *ev_w_in, *ev_a_sink, *ev_b_lambda, *ev_b_subln_g, *ev_w_out;
  const float *od_norm_g, *od_w_ada, *od_b_ada, *od_w_in, *od_q_norm_g, *od_kv_norm_g, *od_w_qb, *od_w_kvb, *od_rpb, *od_w_out, *final_g;
  float* out;
  hf *WinE, *WinO, *WoutE, *WoutO, *Wqb, *Wkvb;
  float *mod;
  float *rope;
  float *lam;
  float *rpb2;
  hf *H;
  hf *P;
  hf *Y;
  hf *QC, *KC;
  float *x1ctx;
  unsigned *bar;
};

DI int crow(int r, int hi) { return (r & 3) + 8 * (r >> 2) + 4 * hi; }
DI float silu_f(float v) { return v * __builtin_amdgcn_rcpf(1.f + __expf(-v)); }
DI f32x16 mfma16(h8 a, h8 b, f32x16 c) { return __builtin_amdgcn_mfma_f32_32x32x16_bf16(__builtin_bit_cast(s16x8, a), __builtin_bit_cast(s16x8, b), c, 0, 0, 0); }
using bf2 = __attribute__((ext_vector_type(2))) __bf16;
DI unsigned cvtpk(float lo, float hi) { bf2 v = {(__bf16)lo, (__bf16)hi}; return __builtin_bit_cast(unsigned, v); }
DI float wave_sum(float v) {
#pragma unroll
  for (int o = 32; o >= 1; o >>= 1) v += __shfl_xor(v, o);
  return v;
}

DI void transpose_tile(const float* __restrict__ W, int K, int N, hf* __restrict__ Wt, int kt, int nt, float* lds) {
  const int tid = threadIdx.x, k0 = kt * 64, n0 = nt * 64;
#pragma unroll
  for (int i = 0; i < 8; ++i) {
    int idx = tid + NTHR * i, kk = idx >> 6, nn = idx & 63;
    lds[kk * 65 + nn] = (n0 + nn < N) ? W[(long)(k0 + kk) * N + n0 + nn] : 0.f;
  }
  __syncthreads();
#pragma unroll
  for (int i = 0; i < 8; ++i) {
    int idx = tid + NTHR * i, nn = idx >> 6, kk = idx & 63;
    Wt[(long)(n0 + nn) * K + k0 + kk] = (hf)lds[kk * 65 + nn];
  }
  __syncthreads();
}

DI void gemv_item(const Params& p, int it, float* lds) {
  const int m = it / 48, cgp = it % 48, tid = threadIdx.x, kq = tid >> 6, col = cgp * 64 + (tid & 63);
  const float* W = m ? p.od_w_ada : p.ev_w_ada;
  const float* bias = m ? p.od_b_ada : p.ev_b_ada;
  float* sc = lds + 1024;
  for (int k = tid; k < 1024; k += NTHR) { sc[k] = silu_f(p.c[k]); sc[1024 + k] = silu_f(p.c_ctx[k]); }
  __syncthreads();
  float a1 = 0.f, a2 = 0.f;
  const float* Wp = W + (long)(kq * 128) * 3072 + col;
#pragma unroll 1
  for (int k0 = 0; k0 < 128; k0 += 16) {
    float w[16];
#pragma unroll
    for (int j = 0; j < 16; ++j) w[j] = Wp[(long)(k0 + j) * 3072];
#pragma unroll
    for (int j = 0; j < 16; ++j) { a1 += sc[kq * 128 + k0 + j] * w[j]; a2 += sc[1024 + kq * 128 + k0 + j] * w[j]; }
  }
  lds[kq * 64 + (tid & 63)] = a1; lds[512 + kq * 64 + (tid & 63)] = a2;
  __syncthreads();
  if (tid < 128) {
    int which = tid >> 6, cc = tid & 63; float s = 0.f;
#pragma unroll
    for (int q = 0; q < 8; ++q) s += lds[which * 512 + q * 64 + cc];
    p.mod[(m * 2 + which) * 3072 + cgp * 64 + cc] = s + bias[cgp * 64 + cc];
  }
  __syncthreads();
}

DI void tables_item(const Params& p) {
  const int tid = threadIdx.x;
  for (int idx = tid; idx < 320 * 16; idx += NTHR) {
    int pos = idx >> 4, i = idx & 15;
    float inv = exp2f(-(float)i * (13.287712379549449f / 16.f));
    if (pos < 256) { float a = (float)pos * inv; p.rope[pos * 16 + i] = cosf(a); p.rope[4096 + pos * 16 + i] = sinf(a); }
    else { int cc = pos - 256; float a = (float)cc * inv; p.rope[8192 + cc * 16 + i] = cosf(a); p.rope[9216 + cc * 16 + i] = sinf(a); }
  }
  for (int idx = tid; idx < 8 * 15 * 32; idx += NTHR) { const int j = idx & 31, hd = idx >> 5; p.rpb2[idx] = j < 31 ? p.od_rpb[hd * 31 + j] * LOG2E : 0.f; }
  if (tid == 0) {
    float s1 = 0.f, s2 = 0.f;
    for (int i = 0; i < 64; ++i) { s1 += p.ev_b_lambda[i] * p.ev_b_lambda[64 + i]; s2 += p.ev_b_lambda[128 + i] * p.ev_b_lambda[192 + i]; }
    p.lam[0] = expf(s1) - expf(s2) + 0.2f;
  }
}

DI void transpose_big(const float* __restrict__ W, int K, int N, hf* __restrict__ Wt, int kt, int nt, float* lds) {
  int tid = threadIdx.x; asm volatile("" : "+v"(tid));
  const int k0 = kt * 64, n0 = nt * 256;
  constexpr int LD = 260;
#pragma unroll
  for (int i = 0; i < 8; ++i) {
    const int f = tid + NTHR * i, kk = f >> 6, n4 = (f & 63) * 4;
    f32x4 v = {0.f, 0.f, 0.f, 0.f};
    if (n0 + n4 < N) v = *(const f32x4*)(W + (long)(k0 + kk) * N + n0 + n4);
    *(f32x4*)(lds + kk * LD + n4) = v;
  }
  __syncthreads();
#pragma unroll
  for (int i = 0; i < 4; ++i) {
    const int c = tid + NTHR * i, nn = c >> 3, kc = (c & 7) * 8;
    h8 o;
#pragma unroll
    for (int j = 0; j < 8; ++j) o[j] = (hf)lds[(kc + j) * LD + nn];
    *(h8*)(Wt + (long)(n0 + nn) * K + k0 + kc) = o;
  }
  __syncthreads();
}

DI void phase_prep(const Params& p, char* lds) {
  float* fl = (float*)lds;
  constexpr int T0 = 97, T_WE = 16 * 13, T_WO = 16 * 12, T_OE = 16 * 4, T_OO = 16 * 4, T_QB = 4 * 3, T_KV = 2 * 4;
  constexpr int NIT = T0 + T_WE + T_WO + T_OE + T_OO + T_QB + T_KV;
  for (int it = blockIdx.x; it < NIT; it += gridDim.x) {
    if (it < 96) { gemv_item(p, it, fl); continue; }
    if (it == 96) { tables_item(p); continue; }
    int t = it - T0;
    if (t < T_WE) { transpose_big(p.ev_w_in, 1024, IN_E, p.WinE, t / 13, t % 13, fl); continue; } t -= T_WE;
    if (t < T_WO) { transpose_big(p.od_w_in, 1024, IN_O, p.WinO, t / 12, t % 12, fl); continue; } t -= T_WO;
    if (t < T_OE) { transpose_big(p.ev_w_out, 1024, 1024, p.WoutE, t / 4, t % 4, fl); continue; } t -= T_OE;
    if (t < T_OO) { transpose_big(p.od_w_out, 1024, 1024, p.WoutO, t / 4, t % 4, fl); continue; } t -= T_OO;
    if (t < T_QB) { transpose_big(p.od_w_qb, 256, 768, p.Wqb, t / 3, t % 3, fl); continue; } t -= T_QB;
    transpose_big(p.od_w_kvb, 128, 1024, p.Wkvb, t / 4, t % 4, fl);
  }
}

DI void phase_modnorm(const Params& p, int layer) {
  int tid = threadIdx.x; asm volatile("" : "+v"(tid));
  const int lane = tid & 63, gw = blockIdx.x * 8 + (tid >> 6), nw = gridDim.x * 8;
  const float* ng = layer ? p.od_norm_g : p.ev_norm_g;
  auto srcrow = [&](int row) -> const float* {
    const bool isc = row >= S_LAT;
    if (layer == 0) return isc ? p.ctx + (long)(row - S_LAT) * DM : p.x + (long)row * DM;
    return isc ? p.x1ctx + (long)(row - S_LAT) * DM : p.out + (long)row * DM;
  };
  for (int row0 = gw; row0 < M_ALL; row0 += 2 * nw) {
    const int row1 = row0 + nw; const bool has1 = row1 < M_ALL;
    const float* s0 = srcrow(row0); const float* s1 = srcrow(has1 ? row1 : row0);
    f32x4 v0[4], v1[4]; float ss0 = 0.f, ss1 = 0.f;
#pragma unroll
    for (int i = 0; i < 4; ++i) { v0[i] = *(const f32x4*)(s0 + lane * 4 + 256 * i); v1[i] = *(const f32x4*)(s1 + lane * 4 + 256 * i); }
#pragma unroll
    for (int i = 0; i < 4; ++i) {
      ss0 += v0[i][0] * v0[i][0] + v0[i][1] * v0[i][1] + v0[i][2] * v0[i][2] + v0[i][3] * v0[i][3];
      ss1 += v1[i][0] * v1[i][0] + v1[i][1] * v1[i][1] + v1[i][2] * v1[i][2] + v1[i][3] * v1[i][3];
    }
    ss0 = wave_sum(ss0); ss1 = wave_sum(ss1);
    const float rstd0 = rsqrtf(ss0 * (1.f / DM) + EPS), rstd1 = rsqrtf(ss1 * (1.f / DM) + EPS);
    const float* md0 = p.mod + (layer * 2 + (row0 >= S_LAT ? 1 : 0)) * 3072;
    const float* md1 = p.mod + (layer * 2 + (row1 >= S_LAT ? 1 : 0)) * 3072;
#pragma unroll
    for (int i = 0; i < 4; ++i) {
      const int cb = lane * 4 + 256 * i;
      const f32x4 g = *(const f32x4*)(ng + cb);
      { const f32x4 sh = *(const f32x4*)(md0 + cb), sc = *(const f32x4*)(md0 + 1024 + cb);
        h4 o;
#pragma unroll
        for (int j = 0; j < 4; ++j) o[j] = (hf)(v0[i][j] * rstd0 * g[j] * (1.f + sc[j]) + sh[j]);
        *(h4*)(p.H + (long)row0 * DM + cb) = o; }
      if (has1) {
        const f32x4 sh = *(const f32x4*)(md1 + cb), sc = *(const f32x4*)(md1 + 1024 + cb);
        h4 o;
#pragma unroll
        for (int j = 0; j < 4; ++j) o[j] = (hf)(v1[i][j] * rstd1 * g[j] * (1.f + sc[j]) + sh[j]);
        *(h4*)(p.H + (long)row1 * DM + cb) = o;
      }
    }
  }
}

DI void phase_mla_rows(const Params& p) {
  int tid = threadIdx.x; asm volatile("" : "+v"(tid));
  const int lane = tid & 63, gw = blockIdx.x * 8 + (tid >> 6), nw = gridDim.x * 8;
  hf* CQN = p.H; hf* CKVN = p.H + (long)M_ALL * 256;
  constexpr int R = 4;
  const f32x4 gq = *(const f32x4*)(p.od_q_norm_g + lane * 4);
  const float gk0 = p.od_kv_norm_g[lane * 2], gk1 = p.od_kv_norm_g[lane * 2 + 1];
  for (int row0 = gw; row0 < M_ALL; row0 += R * nw) {
    int rows[R]; bool ok[R]; h4 q4[R]; float k0[R], k1[R], kr[R], cs[R], sn[R];
#pragma unroll
    for (int u = 0; u < R; ++u) {
      const int rr = row0 + u * nw; ok[u] = rr < M_ALL; rows[u] = ok[u] ? rr : row0;
      const hf* pr = p.P + (long)rows[u] * IN_OP;
      q4[u] = *(const h4*)(pr + lane * 4);
      k0[u] = (float)pr[256 + lane * 2]; k1[u] = (float)pr[256 + lane * 2 + 1];
      kr[u] = (float)pr[384 + lane];
      const int f = lane & 15, row = rows[u];
      if (lane & 32) { cs[u] = p.rope[8192 + (row & 63) * 16 + f]; sn[u] = p.rope[9216 + (row & 63) * 16 + f]; }
      else { cs[u] = p.rope[(row >> 6) * 16 + f]; sn[u] = p.rope[4096 + (row >> 6) * 16 + f]; }
    }
#pragma unroll
    for (int u = 0; u < R; ++u) {
      const int row = rows[u];
      float qf[4], ss = 0.f;
#pragma unroll
      for (int j = 0; j < 4; ++j) { qf[j] = (float)q4[u][j]; ss += qf[j] * qf[j]; }
      ss = wave_sum(ss);
      const float rstd = rsqrtf(ss * (1.f / 256.f) + EPS);
      const float s2 = wave_sum(k0[u] * k0[u] + k1[u] * k1[u]);
      const float rs2 = rsqrtf(s2 * (1.f / 128.f) + EPS);
      float krv = kr[u];
      const float pt = __shfl_xor(krv, 16);
      if (row < S_LAT) krv = krv * cs[u] + ((lane & 16) ? pt : -pt) * sn[u];
      if (ok[u]) {
        h4 o4;
#pragma unroll
        for (int j = 0; j < 4; ++j) o4[j] = (hf)(qf[j] * rstd * gq[j]);
        *(h4*)(CQN + (long)row * 256 + lane * 4) = o4;
        CKVN[(long)row * 128 + lane * 2] = (hf)(k0[u] * rs2 * gk0);
        CKVN[(long)row * 128 + lane * 2 + 1] = (hf)(k1[u] * rs2 * gk1);
        const hf kh = (hf)krv;
#pragma unroll
        for (int h = 0; h < 4; ++h) p.KC[(long)row * 768 + h * 192 + 128 + lane] = kh;
      }
    }
  }
}

DI void phase_final(const Params& p) {
  int tid = threadIdx.x; asm volatile("" : "+v"(tid));
  const int lane = tid & 63, gw = blockIdx.x * 8 + (tid >> 6), nw = gridDim.x * 8;
  for (int row0 = gw; row0 < S_LAT; row0 += 2 * nw) {
    const int row1 = row0 + nw; const bool has1 = row1 < S_LAT;
    float* s0 = p.out + (long)row0 * DM; float* s1 = p.out + (long)(has1 ? row1 : row0) * DM;
    f32x4 v0[4], v1[4]; float ss0 = 0.f, ss1 = 0.f;
#pragma unroll
    for (int i = 0; i < 4; ++i) { v0[i] = *(const f32x4*)(s0 + lane * 4 + 256 * i); v1[i] = *(const f32x4*)(s1 + lane * 4 + 256 * i); }
#pragma unroll
    for (int i = 0; i < 4; ++i) {
      ss0 += v0[i][0] * v0[i][0] + v0[i][1] * v0[i][1] + v0[i][2] * v0[i][2] + v0[i][3] * v0[i][3];
      ss1 += v1[i][0] * v1[i][0] + v1[i][1] * v1[i][1] + v1[i][2] * v1[i][2] + v1[i][3] * v1[i][3];
    }
    ss0 = wave_sum(ss0); ss1 = wave_sum(ss1);
    const float rstd0 = rsqrtf(ss0 * (1.f / DM) + EPS), rstd1 = rsqrtf(ss1 * (1.f / DM) + EPS);
#pragma unroll
    for (int i = 0; i < 4; ++i) {
      const int cb = lane * 4 + 256 * i;
      const f32x4 g = *(const f32x4*)(p.final_g + cb);
      f32x4 o0, o1;
#pragma unroll
      for (int j = 0; j < 4; ++j) { o0[j] = v0[i][j] * rstd0 * g[j]; o1[j] = v1[i][j] * rstd1 * g[j]; }
      *(f32x4*)(s0 + cb) = o0;
      if (has1) *(f32x4*)(s1 + cb) = o1;
    }
  }
}

template <bool TRANS, int TM, int TN, class Epi>
DI void gemm_tile(const hf* __restrict__ A, int lda, const hf* __restrict__ Bt, int ldb, int K, int m0, int n0, char* lds, Epi&& epi) {
  int tid = threadIdx.x; asm volatile("" : "+v"(tid));
  const int wid = __builtin_amdgcn_readfirstlane(tid >> 6), lane = tid & 63, r32 = lane & 31, hi = lane >> 5;
  const int wm = wid >> 1, wn = wid & 1;
  constexpr int ACH = 128 * TM * 8 / NTHR, BCH = 64 * TN * 8 / NTHR;
  char* As = lds; char* Bs = lds + 65536;
  const hf* Ag[ACH]; const hf* Bg[BCH]; int loa[ACH], lob[BCH];
#pragma unroll
  for (int i = 0; i < ACH; ++i) {
    int c = tid + NTHR * i, row = c >> 3, ch = c & 7;
    loa[i] = row * 128 + ((ch ^ ((row >> 1) & 7)) << 4);
    Ag[i] = A + (long)(m0 + row) * lda + ch * 8;
  }
#pragma unroll
  for (int i = 0; i < BCH; ++i) {
    int c = tid + NTHR * i, row = c >> 3, ch = c & 7;
    lob[i] = row * 128 + ((ch ^ ((row >> 1) & 7)) << 4);
    Bg[i] = Bt + (long)(n0 + row) * ldb + ch * 8;
  }
  f32x16 acc[TM][TN];
#pragma unroll
  for (int a = 0; a < TM; ++a)
#pragma unroll
    for (int b = 0; b < TN; ++b)
#pragma unroll
      for (int r = 0; r < 16; ++r) acc[a][b][r] = 0.f;
  h8 ra[ACH], rb[BCH];
#pragma unroll
  for (int i = 0; i < ACH; ++i) ra[i] = *(const h8*)(Ag[i]);
#pragma unroll
  for (int i = 0; i < BCH; ++i) rb[i] = *(const h8*)(Bg[i]);
#pragma unroll
  for (int i = 0; i < ACH; ++i) *(h8*)(As + loa[i]) = ra[i];
#pragma unroll
  for (int i = 0; i < BCH; ++i) *(h8*)(Bs + lob[i]) = rb[i];
  __syncthreads();
  const int nk = K >> 6;
  const int swz = (r32 >> 1) & 7;
  for (int kt = 0; kt < nk; ++kt) {
    const int cur = kt & 1;
    if (kt + 1 < nk) {
#pragma unroll
      for (int i = 0; i < ACH; ++i) ra[i] = *(const h8*)(Ag[i] + (kt + 1) * 64);
#pragma unroll
      for (int i = 0; i < BCH; ++i) rb[i] = *(const h8*)(Bg[i] + (kt + 1) * 64);
    }
    __builtin_amdgcn_sched_barrier(0);
    const char* Ac = As + cur * 32768; const char* Bc = Bs + cur * 32768;
#pragma unroll
    for (int ks = 0; ks < 4; ++ks) {
      const int chs = ((2 * ks + hi) ^ swz) << 4;
      h8 a[TM], b[TN];
#pragma unroll
      for (int tm = 0; tm < TM; ++tm) a[tm] = *(const h8*)(Ac + (wm * (32 * TM) + tm * 32 + r32) * 128 + chs);
#pragma unroll
      for (int tn = 0; tn < TN; ++tn) b[tn] = *(const h8*)(Bc + (wn * (32 * TN) + tn * 32 + r32) * 128 + chs);
#pragma unroll
      for (int tm = 0; tm < TM; ++tm)
#pragma unroll
        for (int tn = 0; tn < TN; ++tn) acc[tm][tn] = TRANS ? mfma16(b[tn], a[tm], acc[tm][tn]) : mfma16(a[tm], b[tn], acc[tm][tn]);
    }
    __builtin_amdgcn_sched_barrier(0);
    if (kt + 1 < nk) {
#pragma unroll
      for (int i = 0; i < ACH; ++i) *(h8*)(As + (cur ^ 1) * 32768 + loa[i]) = ra[i];
#pragma unroll
      for (int i = 0; i < BCH; ++i) *(h8*)(Bs + (cur ^ 1) * 32768 + lob[i]) = rb[i];
    }
    __syncthreads();
  }
#pragma unroll
  for (int tm = 0; tm < TM; ++tm)
#pragma unroll
    for (int tn = 0; tn < TN; ++tn) { epi(m0 + wm * (32 * TM) + tm * 32, n0 + wn * (32 * TN) + tn * 32, acc[tm][tn], r32, hi); __builtin_amdgcn_sched_barrier(0); }
}

using f32x4v = __attribute__((ext_vector_type(4))) float;
DI int p8_lds_byte(int r, int c) {
  int st = (r >> 4) * 2 + (c >> 5), rr = r & 15, cc = c & 31, ob = rr * 64 + cc * 2;
  return st * 1024 + (ob ^ (((ob >> 9) & 1) << 5));
}
DI void p8_stage_rc(int b, int& R, int& C) {
  int st = b / 1024, sb = b % 1024, swz = sb ^ (((sb >> 9) & 1) << 5);
  R = (st >> 1) * 16 + swz / 64; C = (st & 1) * 32 + (swz % 64) / 2;
}
template <class Epi>
DI void gemm_tile_8p(const hf* __restrict__ A, const hf* __restrict__ Bt, int K, int brow, int bcol, char* lds, Epi&& epi) {
  constexpr int BK = 64, HALF = 128, HT = HALF * BK;
  hf* shm = (hf*)lds;
  int tid = threadIdx.x; asm volatile("" : "+v"(tid));
#define SA(b, h) (shm + ((b) * 2 + (h)) * HT)
#define SB(b, h) (shm + (4 + (b) * 2 + (h)) * HT)
#define STAGE(P, BASE, br, kt) do { long _g = (long)(br) * K + (long)(kt) * BK; \
    _Pragma("unroll") for (int _i = 0; _i < 2; ++_i) { int _b = tid * 16 + _i * 8192; int _r, _c; p8_stage_rc(_b, _r, _c); \
      __builtin_amdgcn_global_load_lds((const __attribute__((address_space(1))) unsigned*)(BASE + _g + (long)_r * K + _c), \
        (__attribute__((address_space(3))) unsigned*)((char*)(P) + _b), 16, 0, 0); } } while (0)
#define LDA(dst, b, h) _Pragma("unroll") for (int m = 0; m < 4; ++m) _Pragma("unroll") for (int k = 0; k < 2; ++k) \
    dst[m][k] = *reinterpret_cast<const h8*>((char*)SA(b, h) + p8_lds_byte(wr * 64 + m * 16 + fr, k * 32 + fq * 8))
#define LDB(dst, b, h) _Pragma("unroll") for (int n = 0; n < 2; ++n) _Pragma("unroll") for (int k = 0; k < 2; ++k) \
    dst[n][k] = *reinterpret_cast<const h8*>((char*)SB(b, h) + p8_lds_byte(wc * 32 + n * 16 + fr, k * 32 + fq * 8))
#define MMA(ai, bj, At_, Bt_) do { __builtin_amdgcn_s_setprio(1); \
    _Pragma("unroll") for (int m = 0; m < 4; ++m) _Pragma("unroll") for (int n = 0; n < 2; ++n) _Pragma("unroll") for (int k = 0; k < 2; ++k) \
      acc[ai][bj][m][n] = __builtin_amdgcn_mfma_f32_16x16x32_bf16(__builtin_bit_cast(s16x8, At_[m][k]), __builtin_bit_cast(s16x8, Bt_[n][k]), acc[ai][bj][m][n], 0, 0, 0); \
    __builtin_amdgcn_s_setprio(0); } while (0)
#define WAIT_V(n) asm volatile("s_waitcnt vmcnt(" #n ")" ::: "memory")
#define WAIT_L(n) asm volatile("s_waitcnt lgkmcnt(" #n ")" ::: "memory")
#define BAR __builtin_amdgcn_s_barrier()
#define SCHED __builtin_amdgcn_sched_barrier(0)
  const int wid = __builtin_amdgcn_readfirstlane(tid >> 6), lane = tid & 63, wr = wid >> 2, wc = wid & 3, fr = lane & 15, fq = lane >> 4;
  f32x4v acc[2][2][4][2];
#pragma unroll
  for (int a = 0; a < 2; ++a)
#pragma unroll
    for (int b = 0; b < 2; ++b)
#pragma unroll
      for (int m = 0; m < 4; ++m)
#pragma unroll
        for (int n = 0; n < 2; ++n) acc[a][b][m][n] = f32x4v{0.f, 0.f, 0.f, 0.f};
  h8 At[4][2], B0[2][2], B1[2][2];
  const int nt = K / BK;
  STAGE(SB(0, 0), Bt, bcol, 0); STAGE(SA(0, 0), A, brow, 0);
  STAGE(SB(0, 1), Bt, bcol + HALF, 0); STAGE(SA(0, 1), A, brow + HALF, 0);
  if (wr == 1) BAR;
  WAIT_V(4); BAR;
  STAGE(SB(1, 0), Bt, bcol, 1); STAGE(SA(1, 0), A, brow, 1); STAGE(SB(1, 1), Bt, bcol + HALF, 1);
  WAIT_V(6); BAR;
  for (int t = 0; t < nt - 2; t += 2) {
    LDB(B0, 0, 0); SCHED; LDA(At, 0, 0); STAGE(SA(1, 1), A, brow + HALF, t + 1);
    WAIT_L(8); BAR; WAIT_L(0); MMA(0, 0, At, B0); BAR; SCHED;
    LDB(B1, 0, 1); STAGE(SB(0, 0), Bt, bcol, t + 2);
    BAR; WAIT_L(0); MMA(0, 1, At, B1); BAR;
    LDA(At, 0, 1); STAGE(SA(0, 0), A, brow, t + 2);
    BAR; WAIT_L(0); MMA(1, 0, At, B0); BAR; SCHED;
    STAGE(SB(0, 1), Bt, bcol + HALF, t + 2);
    WAIT_V(6); BAR; MMA(1, 1, At, B1); BAR;
    LDB(B0, 1, 0); SCHED; LDA(At, 1, 0); STAGE(SA(0, 1), A, brow + HALF, t + 2);
    WAIT_L(8); BAR; WAIT_L(0); MMA(0, 0, At, B0); BAR; SCHED;
    LDB(B1, 1, 1); STAGE(SB(1, 0), Bt, bcol, t + 3);
    BAR; WAIT_L(0); MMA(0, 1, At, B1); BAR;
    LDA(At, 1, 1); STAGE(SA(1, 0), A, brow, t + 3);
    BAR; WAIT_L(0); MMA(1, 0, At, B0); BAR; SCHED;
    STAGE(SB(1, 1), Bt, bcol + HALF, t + 3);
    WAIT_V(6); BAR; MMA(1, 1, At, B1); BAR;
  }
  { LDB(B0, 0, 0); LDA(At, 0, 0); STAGE(SA(1, 1), A, brow + HALF, nt - 1);
    BAR; WAIT_L(0); MMA(0, 0, At, B0); BAR;
    LDB(B1, 0, 1); BAR; WAIT_L(0); MMA(0, 1, At, B1); BAR;
    LDA(At, 0, 1); WAIT_V(4); BAR; WAIT_L(0); MMA(1, 0, At, B0); MMA(1, 1, At, B1); BAR; }
  { LDB(B0, 1, 0); LDA(At, 1, 0); WAIT_V(2); BAR; WAIT_L(0); MMA(0, 0, At, B0); BAR;
    LDB(B1, 1, 1); WAIT_V(0); BAR; WAIT_L(0); MMA(0, 1, At, B1); BAR;
    LDA(At, 1, 1); BAR; WAIT_L(0); MMA(1, 0, At, B0); MMA(1, 1, At, B1); BAR; }
  if (wr == 0) BAR;
#pragma unroll
  for (int ai = 0; ai < 2; ++ai)
#pragma unroll
    for (int bj = 0; bj < 2; ++bj) { epi(brow + ai * HALF + wr * 64, bcol + bj * HALF + wc * 32, acc[ai][bj], fr, fq); SCHED; }
  __syncthreads();
#undef SA
#undef SB
#undef STAGE
#undef LDA
#undef LDB
#undef MMA
#undef WAIT_V
#undef WAIT_L
#undef BAR
#undef SCHED
}

DI void raster(int v, int MT, int NT, int& mt, int& nt) {
  const int grp = v / (8 * NT), fm = grp * 8, rows = (MT - fm) < 8 ? (MT - fm) : 8, r = v - grp * 8 * NT;
  mt = fm + r % rows; nt = r / rows;
}
template <bool TRANS, class Epi>
DI void gemm_phase(const hf* __restrict__ A, int lda, const hf* __restrict__ Bt, int ldb, int K, int MT, int NT, char* lds, Epi&& epi) {
  const int T = MT * NT, G = gridDim.x, full = (T / G) * G;
  for (int base = 0; base < full; base += G) {
    int v;
    if ((G & 7) == 0) v = base + (blockIdx.x & 7) * (G >> 3) + (blockIdx.x >> 3); else v = base + blockIdx.x;
    int mt, nt; raster(v, MT, NT, mt, nt);
    gemm_tile<TRANS, 2, 4>(A, lda, Bt, ldb, K, mt * 256, nt * 256, lds, epi);
  }
  const int R4 = (T - full) * 4;
  for (int q = blockIdx.x; q < R4; q += G) {
    int mt, nt; raster(full + (q >> 2), MT, NT, mt, nt);
    gemm_tile<TRANS, 1, 2>(A, lda, Bt, ldb, K, mt * 256 + ((q >> 1) & 1) * 128, nt * 256 + (q & 1) * 128, lds, epi);
  }
}

template <bool TRANS, class Epi8, class EpiQ>
DI void gemm_phase8(const hf* __restrict__ A, const hf* __restrict__ Bt, int K, int MT, int NT, char* lds, Epi8&& epi8, EpiQ&& epiq) {
  const int T = MT * NT, G = gridDim.x, full = (T / G) * G;
  for (int base = 0; base < full; base += G) {
    int v;
    if ((G & 7) == 0) v = base + (blockIdx.x & 7) * (G >> 3) + (blockIdx.x >> 3); else v = base + blockIdx.x;
    int mt, nt; raster(v, MT, NT, mt, nt);
    if (TRANS) gemm_tile_8p(Bt, A, K, nt * 256, mt * 256, lds, epi8);
    else gemm_tile_8p(A, Bt, K, mt * 256, nt * 256, lds, epi8);
  }
  const int R4 = (T - full) * 4;
  for (int q = blockIdx.x; q < R4; q += G) {
    int mt, nt; raster(full + (q >> 2), MT, NT, mt, nt);
    gemm_tile<TRANS, 1, 2>(A, K, Bt, K, K, mt * 256 + ((q >> 1) & 1) * 128, nt * 256 + (q & 1) * 128, lds, epiq);
  }
}
DI void rope_blk8(const Params& p, float (&v)[4][4], int tok, int fq) {
  const float* cr = p.rope + (tok >> 6) * 16 + fq * 4;
  const float* cc = p.rope + 8192 + (tok & 63) * 16 + fq * 4;
  const f32x4 c0 = *(const f32x4*)cr, s0 = *(const f32x4*)(cr + 4096), c1 = *(const f32x4*)cc, s1 = *(const f32x4*)(cc + 1024);
#pragma unroll
  for (int j = 0; j < 4; ++j) {
    { const float a = v[0][j], b = v[1][j]; v[0][j] = a * c0[j] - b * s0[j]; v[1][j] = b * c0[j] + a * s0[j]; }
    { const float a = v[2][j], b = v[3][j]; v[2][j] = a * c1[j] - b * s1[j]; v[3][j] = b * c1[j] + a * s1[j]; }
  }
}
DI void store_blk8(hf* base, const float (&v)[4][4], int fq) {
#pragma unroll
  for (int m = 0; m < 4; ++m) {
    h4 o = {(hf)v[m][0], (hf)v[m][1], (hf)v[m][2], (hf)v[m][3]};
    *(h4*)(base + m * 16 + fq * 4) = o;
  }
}

DI void rope_tile(const Params& p, float (&v)[16], int tok, int cb, int hi) {
  const float* ct = (cb & 32) ? p.rope + 8192 + (tok & 63) * 16 : p.rope + (tok >> 6) * 16;
  const float* st = (cb & 32) ? ct + 1024 : ct + 4096;
  const f32x4 c0 = *(const f32x4*)(ct + 4 * hi), c1 = *(const f32x4*)(ct + 8 + 4 * hi);
  const f32x4 s0 = *(const f32x4*)(st + 4 * hi), s1 = *(const f32x4*)(st + 8 + 4 * hi);
#pragma unroll
  for (int j = 0; j < 4; ++j) {
    { const float a = v[j], b = v[j + 8]; v[j] = a * c0[j] - b * s0[j]; v[j + 8] = b * c0[j] + a * s0[j]; }
    { const float a = v[4 + j], b = v[12 + j]; v[4 + j] = a * c1[j] - b * s1[j]; v[12 + j] = b * c1[j] + a * s1[j]; }
  }
}
DI void store_tile_h(hf* base, const float (&v)[16], int hi) {
#pragma unroll
  for (int g = 0; g < 4; ++g) {
    h4 o = {(hf)v[4 * g], (hf)v[4 * g + 1], (hf)v[4 * g + 2], (hf)v[4 * g + 3]};
    *(h4*)(base + 8 * g + 4 * hi) = o;
  }
}

DI void phase_inproj_even(const Params& p, char* lds) {
  constexpr int NT = IN_E / 256, MT = M_ALL / 256;
  const float qs = 0.125f * LOG2E;
  {
    gemm_phase8<true>(p.H, p.WinE, DM, MT, NT, lds, [&](int fb, int tb, f32x4v (&q)[4][2], int fr, int fq) {
      int kind;
      if (fb < 512) kind = 2; else if (fb < 640) kind = 1; else if (fb < 768) kind = 0; else if (fb < 1280) kind = 2;
      else if (fb < 1792) kind = 1; else if (fb < 2304) kind = 0; else kind = 3;
#pragma unroll
      for (int n = 0; n < 2; ++n) {
        const int tok = tb + n * 16 + fr;
        float v[4][4];
#pragma unroll
        for (int m = 0; m < 4; ++m)
#pragma unroll
          for (int j = 0; j < 4; ++j) v[m][j] = q[m][n][j];
        if ((kind == 1 || kind == 2) && tb < S_LAT) rope_blk8(p, v, tok, fq);
        if (kind == 2) {
#pragma unroll
          for (int m = 0; m < 4; ++m)
#pragma unroll
            for (int j = 0; j < 4; ++j) v[m][j] *= qs;
        } else if (kind == 3) {
#pragma unroll
          for (int m = 0; m < 4; ++m)
#pragma unroll
            for (int j = 0; j < 4; ++j) v[m][j] = silu_f(v[m][j]);
        }
        store_blk8(p.P + (size_t)tok * IN_E + fb, v, fq);
      }
    }, [&](int rb, int cb, const f32x16& acc, int r32, int hi) {
      int kind;
      if (cb < 512) kind = 2; else if (cb < 640) kind = 1; else if (cb < 768) kind = 0; else if (cb < 1280) kind = 2;
      else if (cb < 1792) kind = 1; else if (cb < 2304) kind = 0; else kind = 3;
      const int tok = rb + r32;
      float v[16];
#pragma unroll
      for (int i = 0; i < 16; ++i) v[i] = acc[i];
      if ((kind == 1 || kind == 2) && rb < S_LAT) rope_tile(p, v, tok, cb, hi);
      if (kind == 2) {
#pragma unroll
        for (int i = 0; i < 16; ++i) v[i] *= qs;
      } else if (kind == 3) {
#pragma unroll
        for (int i = 0; i < 16; ++i) v[i] = silu_f(v[i]);
      }
      store_tile_h(p.P + (size_t)tok * IN_E + cb, v, hi);
    });
  }
}

DI void phase_inproj_odd(const Params& p, char* lds) {
  constexpr int NT = IN_OP / 256, MT = M_ALL / 256;
  const float qs = 0.125f * LOG2E;
  {
    gemm_phase8<true>(p.H, p.WinO, DM, MT, NT, lds, [&](int fb, int tb, f32x4v (&q)[4][2], int fr, int fq) {
      if (fb >= IN_O) return;
      const int kind = (fb >= 1984) ? 3 : ((fb >= 448 && fb < 960) ? 2 : 0);
#pragma unroll
      for (int n = 0; n < 2; ++n) {
        const int tok = tb + n * 16 + fr;
        float v[4][4];
#pragma unroll
        for (int m = 0; m < 4; ++m)
#pragma unroll
          for (int j = 0; j < 4; ++j) v[m][j] = q[m][n][j];
        if (kind == 2) {
#pragma unroll
          for (int m = 0; m < 4; ++m)
#pragma unroll
            for (int j = 0; j < 4; ++j) v[m][j] *= qs;
        } else if (kind == 3) {
#pragma unroll
          for (int m = 0; m < 4; ++m)
#pragma unroll
            for (int j = 0; j < 4; ++j) v[m][j] = silu_f(v[m][j]);
        }
        store_blk8(p.P + (size_t)tok * IN_OP + fb, v, fq);
      }
    }, [&](int rb, int cb, const f32x16& acc, int r32, int hi) {
      if (cb >= IN_O) return;
      const int kind = (cb >= 1984) ? 3 : ((cb >= 448 && cb < 960) ? 2 : 0);
      const int tok = rb + r32;
      float v[16];
#pragma unroll
      for (int i = 0; i < 16; ++i) v[i] = acc[i];
      if (kind == 2) {
#pragma unroll
        for (int i = 0; i < 16; ++i) v[i] *= qs;
      } else if (kind == 3) {
#pragma unroll
        for (int i = 0; i < 16; ++i) v[i] = silu_f(v[i]);
      }
      store_tile_h(p.P + (size_t)tok * IN_OP + cb, v, hi);
    });
  }
}

DI void phase_mla_proj(const Params& p, char* lds) {
  constexpr int MT = M_ALL / 256;
  const hf* CQN = p.H; const hf* CKVN = p.H + (long)M_ALL * 256; hf* VC = p.H + (long)M_ALL * 384;
  const float qs = 0.07216878364870322f * LOG2E;
  gemm_phase8<true>(CQN, p.Wqb, 256, MT, 3, lds, [&](int fb, int tb, f32x4v (&q)[4][2], int fr, int fq) {
    const bool pe = (fb % 192) >= 128;
#pragma unroll
    for (int n = 0; n < 2; ++n) {
      const int tok = tb + n * 16 + fr;
      float v[4][4];
#pragma unroll
      for (int m = 0; m < 4; ++m)
#pragma unroll
        for (int j = 0; j < 4; ++j) v[m][j] = q[m][n][j];
      if (pe && tb < S_LAT) rope_blk8(p, v, tok, fq);
#pragma unroll
      for (int m = 0; m < 4; ++m)
#pragma unroll
        for (int j = 0; j < 4; ++j) v[m][j] *= qs;
      store_blk8(p.QC + (size_t)tok * 768 + fb, v, fq);
    }
  }, [&](int rb, int cb, const f32x16& acc, int r32, int hi) {
    const bool pe = (cb % 192) >= 128;
    const int tok = rb + r32;
    float v[16];
#pragma unroll
    for (int i = 0; i < 16; ++i) v[i] = acc[i];
    if (pe && rb < S_LAT) rope_tile(p, v, tok, cb, hi);
#pragma unroll
    for (int i = 0; i < 16; ++i) v[i] *= qs;
    store_tile_h(p.QC + (size_t)tok * 768 + cb, v, hi);
  });
  gemm_phase<true>(CKVN, 128, p.Wkvb, 128, 128, MT, 4, lds, [&](int rb, int cb, const f32x16& acc, int r32, int hi) {
    const int h = cb >> 8, w = cb & 255;
    const int tok = rb + r32;
    float v[16];
#pragma unroll
    for (int i = 0; i < 16; ++i) v[i] = acc[i];
    if (w < 128) store_tile_h(p.KC + (size_t)tok * 768 + h * 192 + w, v, hi);
    else store_tile_h(VC + (size_t)tok * 512 + h * 128 + (w - 128), v, hi);
  });
}

DI void phase_outproj(const Params& p, int layer, char* lds) {
  const int MT = layer ? S_LAT / 256 : M_ALL / 256;
  const hf* W = layer ? p.WoutO : p.WoutE;
  {
    gemm_phase8<false>(p.Y, W, DM, MT, 4, lds, [&](int rb, int cb, f32x4v (&q)[4][2], int fr, int fq) {
      const bool isc = rb >= S_LAT;
#pragma unroll
      for (int n = 0; n < 2; ++n) {
        const int col = cb + n * 16 + fr;
        const float g = p.mod[(layer * 2 + (isc ? 1 : 0)) * 3072 + 2048 + col];
        const float* src; float* dst;
        if (layer == 0) { if (isc) { src = p.ctx + (size_t)(rb - S_LAT) * DM + col; dst = p.x1ctx + (size_t)(rb - S_LAT) * DM + col; }
                          else { src = p.x + (size_t)rb * DM + col; dst = p.out + (size_t)rb * DM + col; } }
        else { src = p.out + (size_t)rb * DM + col; dst = p.out + (size_t)rb * DM + col; }
#pragma unroll
        for (int m = 0; m < 4; ++m)
#pragma unroll
          for (int j = 0; j < 4; ++j) { const int ro = (m * 16 + fq * 4 + j) * DM; dst[ro] = src[ro] + g * q[m][n][j]; }
      }
    }, [&](int rb, int cb, const f32x16& acc, int r32, int hi) {
      const bool isc = rb >= S_LAT;
      const int col = cb + r32;
      const float g = p.mod[(layer * 2 + (isc ? 1 : 0)) * 3072 + 2048 + col];
      const float* src; float* dst;
      if (layer == 0) { if (isc) { src = p.ctx + (size_t)(rb - S_LAT) * DM + col; dst = p.x1ctx + (size_t)(rb - S_LAT) * DM + col; }
                        else { src = p.x + (size_t)rb * DM + col; dst = p.out + (size_t)rb * DM + col; } }
      else { src = p.out + (size_t)rb * DM + col; dst = p.out + (size_t)rb * DM + col; }
#pragma unroll
      for (int i = 0; i < 16; ++i) { const int ro = crow(i, hi) * DM; dst[ro] = src[ro] + g * acc[i]; }
    });
  }
}

DI int v_st(int k, int c) { const int kk = (k & ~0xC) | ((k & 4) << 1) | ((k & 8) >> 1); return ((kk >> 3) * 4 + (c >> 5)) * 512 + ((kk & 7) * 32 + (c & 31)) * 2; }
DI int v_rd_base(int lane) { return ((lane & 3) << 3) | (((lane >> 2) & 3) << 6) | (((lane >> 4) & 1) << 5) | (((lane >> 5) & 1) << 8); }
constexpr int v_rd_off(int d0, int ks, int half) { return d0 * 512 + ks * 4096 + half * 2048; }
template <int OFF> DI s16x4 tr_read(int vb) {
  s16x4 r; asm volatile("ds_read_b64_tr_b16 %0, %1 offset:%2" : "=&v"(r) : "v"(vb), "i"(OFF) : "memory"); return r;
}
DI h8 pk8(s16x4 l, s16x4 h) {
  using s16x8 = __attribute__((ext_vector_type(8))) short;
  s16x8 v = {l[0], l[1], l[2], l[3], h[0], h[1], h[2], h[3]};
  return __builtin_bit_cast(h8, v);
}
template <int D0> DI void pv_reads(int vb, s16x4 (&r)[8]) {
  r[0] = tr_read<v_rd_off(D0, 0, 0)>(vb); r[1] = tr_read<v_rd_off(D0, 0, 1)>(vb); r[2] = tr_read<v_rd_off(D0, 1, 0)>(vb); r[3] = tr_read<v_rd_off(D0, 1, 1)>(vb);
  r[4] = tr_read<v_rd_off(D0, 2, 0)>(vb); r[5] = tr_read<v_rd_off(D0, 2, 1)>(vb); r[6] = tr_read<v_rd_off(D0, 3, 0)>(vb); r[7] = tr_read<v_rd_off(D0, 3, 1)>(vb);
}
DI void pv_mfma(f32x16& od, const s16x4 (&r)[8], h8 pa0, h8 pa1, h8 pa2, h8 pa3) {
  od = mfma16(pa0, pk8(r[0], r[1]), od);
  od = mfma16(pa1, pk8(r[2], r[3]), od);
  od = mfma16(pa2, pk8(r[4], r[5]), od);
  od = mfma16(pa3, pk8(r[6], r[7]), od);
}
#define LGKM_WAIT(n) do { asm volatile("s_waitcnt lgkmcnt(" #n ")" ::: "memory"); __builtin_amdgcn_sched_barrier(0); } while (0)
template <int ND> DI void pv_tile(f32x16 (&o)[ND], int vb, h8 pa0, h8 pa1, h8 pa2, h8 pa3) {
  s16x4 ra[8], rb[8];
  __builtin_amdgcn_sched_barrier(0);
  pv_reads<0>(vb, ra); pv_reads<1>(vb, rb);
  LGKM_WAIT(8); pv_mfma(o[0], ra, pa0, pa1, pa2, pa3);
  if constexpr (ND > 2) {
    __builtin_amdgcn_sched_barrier(0);
    pv_reads<2>(vb, ra);
    LGKM_WAIT(8); pv_mfma(o[1], rb, pa0, pa1, pa2, pa3);
    __builtin_amdgcn_sched_barrier(0);
    pv_reads<3>(vb, rb);
    LGKM_WAIT(8); pv_mfma(o[2], ra, pa0, pa1, pa2, pa3);
    LGKM_WAIT(0); pv_mfma(o[3], rb, pa0, pa1, pa2, pa3);
  } else {
    LGKM_WAIT(0); pv_mfma(o[1], rb, pa0, pa1, pa2, pa3);
  }
  __builtin_amdgcn_sched_barrier(0);
}

template <int DK, int DV, int MODE>
DI void attn_core(const hf* __restrict__ Qp, int ldq, const hf* __restrict__ Kp, int ldk, const hf* __restrict__ Vp, int ldv,
                  int q0, int nctx, int ctx_base, int loc_base, int ntot, const float* __restrict__ rpb_h,
                  f32x16 (&o)[DV / 32], float& l_out, float& m_out, char* lds) {
  int tid = threadIdx.x; asm volatile("" : "+v"(tid));
  const int wid = __builtin_amdgcn_readfirstlane(tid >> 6), lane = tid & 63, r32 = lane & 31, hi = lane >> 5;
  constexpr int KB = 64 * DK * 2, NKC = DK / 8, KCH = 64 * NKC / NTHR, NVC = DV / 8, VCH = 64 * NVC / NTHR;
  constexpr int ND = DV / 32;
  char* Vl = lds; char* Kl = lds + 49152; float* wsf = (float*)(lds + 98304) + wid * 64;
  constexpr int grp = 0;
  h8 qr[DK / 16];
  {
    const hf* Qw = Qp + (long)(q0 + wid * 32 + r32) * ldq + hi * 8;
#pragma unroll
    for (int d0 = 0; d0 < DK / 16; ++d0) qr[d0] = *(const h8*)(Qw + d0 * 16);
  }
  int kgo[KCH], klo[KCH], vgo[VCH], vlo[VCH];
#pragma unroll
  for (int i = 0; i < KCH; ++i) { int c = tid + NTHR * i, row = c / NKC, ch = c % NKC; kgo[i] = row * ldk + ch * 8; klo[i] = row * (DK * 2) + ((ch * 16) ^ (((row >> 1) & 7) << 4)); }
#pragma unroll
  for (int i = 0; i < VCH; ++i) { int c = tid + NTHR * i, row = c / NVC, ch = c % NVC; vgo[i] = row * ldv + ch * 8; vlo[i] = v_st(row, ch * 8); }
  h8 ks[KCH], vs[VCH];
  const int qpos = q0 + wid * 32 + r32;
  const int krow_ = (r32 & ~12) | ((r32 & 4) << 1) | ((r32 & 8) >> 1);
  const int kswz = ((krow_ >> 1) & 7) << 4;
  const int vb0 = (int)(uintptr_t)Vl + v_rd_base(lane);
  constexpr float THR = 8.f;
  float m_reg = 0.f, l_reg = 0.f;
  f32x16 negm;
#pragma unroll
  for (int r = 0; r < 16; ++r) negm[r] = 0.f;
#pragma unroll
  for (int d = 0; d < ND; ++d)
#pragma unroll
    for (int r = 0; r < 16; ++r) o[d][r] = 0.f;

#define TSTART(t) ((t) < nctx ? ctx_base + 64 * (t) : loc_base + 64 * ((t) - nctx))
#define SLOAD(t) do { const long kb_ = TSTART(t); _Pragma("unroll") for (int i = 0; i < KCH; ++i) ks[i] = *(const h8*)(Kp + kb_ * ldk + kgo[i]); \
    _Pragma("unroll") for (int i = 0; i < VCH; ++i) vs[i] = *(const h8*)(Vp + kb_ * ldv + vgo[i]); } while (0)
#define SWRITE(b, vbuf) do { _Pragma("unroll") for (int i = 0; i < KCH; ++i) *(h8*)(Kl + (b) * KB + klo[i]) = ks[i]; \
    _Pragma("unroll") for (int i = 0; i < VCH; ++i) *(h8*)(Vl + (vbuf) * 16384 + vlo[i]) = vs[i]; } while (0)
#define DO_PV(vb_) pv_tile<ND>(o, (vb_), pa0, pa1, pa2, pa3)

  h8 pa0, pa1, pa2, pa3;
  bool pact = false;
  int vcur = 0, vprev = 0;
  SLOAD(0); SWRITE(0, 0); __syncthreads();
  for (int t = 0; t < ntot; ++t) {
    const int cur = t & 1;
    const int vnext = vcur == 2 ? 0 : vcur + 1;
    if (t + 1 < ntot) SLOAD(t + 1);
    __builtin_amdgcn_sched_barrier(0);
    if (grp == 1 && pact) DO_PV(vb0 + vprev * 16384);
    bool active = true;
    int kr_ = 0, r_ = 0, c_ = 0, cs_ = 0;
    const int tstart = TSTART(t);
    if (MODE == 2 && t >= nctx) {
      kr_ = tstart >> 6; r_ = qpos >> 6; c_ = qpos & 63;
      int rs = r_ - 4; rs = rs < 0 ? 0 : (rs > 248 ? 248 : rs);
      cs_ = c_ - 8; cs_ = cs_ < 0 ? 0 : (cs_ > 48 ? 48 : cs_);
      active = (kr_ >= rs) && (kr_ < rs + 8);
    }
    bool need_mask = true;
    if (MODE == 1 && t >= nctx) {
      const int w0 = q0 + wid * 32;
      active = !((tstart + 63 < w0 - 128) || (tstart > w0 + 31 + 128));
      need_mask = !((tstart >= w0 + 31 - 128) && (tstart + 63 <= w0 + 128));
    }
    if (active) {
      f32x16 p0, p1;
      float alpha = 1.f, ps;
      constexpr bool SKIPMAX = (DV == 128 && MODE == 0);
      bool redo = !SKIPMAX || (t == 0);
      for (;;) {
      p0 = negm; p1 = negm;
      const char* Kc = Kl + cur * KB;
#pragma unroll
      for (int d0 = 0; d0 < DK / 16; ++d0) {
        const int cb = (d0 * 32 + hi * 16) ^ kswz;
        h8 b0 = *(const h8*)(Kc + krow_ * (DK * 2) + cb);
        h8 b1 = *(const h8*)(Kc + (32 + krow_) * (DK * 2) + cb);
        p0 = mfma16(b0, qr[d0], p0);
        p1 = mfma16(b1, qr[d0], p1);
        if (DK > 64 && (d0 & 3) == 3) __builtin_amdgcn_sched_barrier(0);
      }
      if (MODE == 1 && t >= nctx && need_mask) {
#pragma unroll
        for (int r = 0; r < 16; ++r) {
          const int kk_ = 16 * (r >> 3) + 8 * hi + (r & 7);
          int d0_ = qpos - (tstart + kk_); d0_ = d0_ < 0 ? -d0_ : d0_;
          int d1_ = qpos - (tstart + 32 + kk_); d1_ = d1_ < 0 ? -d1_ : d1_;
          p0[r] = d0_ <= 128 ? p0[r] : NEGV;
          p1[r] = d1_ <= 128 ? p1[r] : NEGV;
        }
      }
      if (MODE == 2 && t >= nctx) {
        const float* rb_ = rpb_h + (kr_ - r_ + 7) * 32;
        const int cb15 = 15 - c_;
#pragma unroll
        for (int r = 0; r < 16; ++r) {
          const int kc0 = 16 * (r >> 3) + 8 * hi + (r & 7), kc1 = 32 + kc0;
          const float b0 = rb_[(kc0 + cb15) & 31], b1 = rb_[(kc1 + cb15) & 31];
          p0[r] = ((unsigned)(kc0 - cs_) < 16u) ? p0[r] + b0 : NEGV;
          p1[r] = ((unsigned)(kc1 - cs_) < 16u) ? p1[r] + b1 : NEGV;
        }
      }
      if (redo) {
        float pm0 = fmaxf(p0[0], p0[1]), pm1 = fmaxf(p0[2], p0[3]), pm2 = fmaxf(p1[0], p1[1]), pm3 = fmaxf(p1[2], p1[3]);
#pragma unroll
        for (int r = 4; r < 16; r += 4) {
          pm0 = fmaxf(pm0, fmaxf(p0[r], p0[r + 1])); pm1 = fmaxf(pm1, fmaxf(p0[r + 2], p0[r + 3]));
          pm2 = fmaxf(pm2, fmaxf(p1[r], p1[r + 1])); pm3 = fmaxf(pm3, fmaxf(p1[r + 2], p1[r + 3]));
        }
        float pmax = fmaxf(fmaxf(pm0, pm1), fmaxf(pm2, pm3));
        { auto rr = __builtin_amdgcn_permlane32_swap(__float_as_uint(pmax), __float_as_uint(pmax), false, false);
          pmax = fmaxf(__uint_as_float(rr[0]), __uint_as_float(rr[1])); }
        if (SKIPMAX || t == 0 || __any(pmax > THR)) {
          const float delta = (t == 0) ? pmax : fmaxf(pmax, 0.f);
#pragma unroll
          for (int r = 0; r < 16; ++r) { p0[r] -= delta; p1[r] -= delta; }
          if (t != 0) alpha = __builtin_amdgcn_exp2f(-delta);
          m_reg += delta;
#pragma unroll
          for (int r = 0; r < 16; ++r) negm[r] = -m_reg;
        }
      }
      float ps0 = 0.f, ps1 = 0.f, ps2 = 0.f, ps3 = 0.f;
#pragma unroll
      for (int r = 0; r < 16; r += 2) {
        p0[r] = __builtin_amdgcn_exp2f(p0[r]); ps0 += p0[r]; p0[r + 1] = __builtin_amdgcn_exp2f(p0[r + 1]); ps1 += p0[r + 1];
        p1[r] = __builtin_amdgcn_exp2f(p1[r]); ps2 += p1[r]; p1[r + 1] = __builtin_amdgcn_exp2f(p1[r + 1]); ps3 += p1[r + 1];
      }
      ps = (ps0 + ps1) + (ps2 + ps3);
      { auto rr = __builtin_amdgcn_permlane32_swap(__float_as_uint(ps), __float_as_uint(ps), false, false);
        ps = __uint_as_float(rr[0]) + __uint_as_float(rr[1]); }
      if (!redo && __any(!(ps <= 16384.f))) { redo = true; continue; }
      break;
      }
      l_reg = l_reg * alpha + ps;
#define PK8(P, BASE, OUT) do { u32x4 w = {cvtpk(P[BASE + 0], P[BASE + 1]), cvtpk(P[BASE + 2], P[BASE + 3]), cvtpk(P[BASE + 4], P[BASE + 5]), cvtpk(P[BASE + 6], P[BASE + 7])}; \
    OUT = __builtin_bit_cast(h8, w); } while (0)
      PK8(p0, 0, pa0); PK8(p0, 8, pa1); PK8(p1, 0, pa2); PK8(p1, 8, pa3);
#undef PK8
      if (__any(alpha < 1.f)) {
        if (hi == 0) wsf[r32] = alpha;
        __builtin_amdgcn_wave_barrier();
        float al[16];
#pragma unroll
        for (int r = 0; r < 16; ++r) al[r] = wsf[crow(r, hi)];
#pragma unroll
        for (int d = 0; d < ND; ++d)
#pragma unroll
          for (int r = 0; r < 16; ++r) o[d][r] *= al[r];
        __builtin_amdgcn_wave_barrier();
      }
      if (grp == 0) DO_PV(vb0 + vcur * 16384);
    }
    pact = active;
    __builtin_amdgcn_sched_barrier(0);
    if (t + 1 < ntot) SWRITE(cur ^ 1, vnext);
    vprev = vcur; vcur = vnext;
    __syncthreads();
  }
  if (grp == 1 && pact) DO_PV(vb0 + vprev * 16384);
  __syncthreads();
#undef DO_PV
#undef SLOAD
#undef SWRITE
#undef TSTART
  l_out = l_reg; m_out = m_reg;
}

template <int DK, int DV>
DI void attn_core_pipe(const hf* __restrict__ Qp, int ldq, const hf* __restrict__ Kp, int ldk, const hf* __restrict__ Vp, int ldv,
                       int q0, int kbase, int ntot, f32x16 (&o)[DV / 32], float& l_out, float& m_out, char* lds) {
  int tid = threadIdx.x; asm volatile("" : "+v"(tid));
  const int wid = __builtin_amdgcn_readfirstlane(tid >> 6), lane = tid & 63, r32 = lane & 31, hi = lane >> 5;
  constexpr int KB = 64 * DK * 2, NKC = DK / 8, KCH = 64 * NKC / NTHR, NVC = DV / 8, VCH = 64 * NVC / NTHR;
  constexpr int ND = DV / 32;
  static_assert(3 * KB <= 49152, "K ring must fit its region");
  char* Vl = lds; char* Kl = lds + 49152; float* wsf = (float*)(lds + 98304) + wid * 64;
  h8 qr[DK / 16];
  {
    const hf* Qw = Qp + (long)(q0 + wid * 32 + r32) * ldq + hi * 8;
#pragma unroll
    for (int d0 = 0; d0 < DK / 16; ++d0) qr[d0] = *(const h8*)(Qw + d0 * 16);
  }
  int kgo[KCH], klo[KCH], vgo[VCH], vlo[VCH];
#pragma unroll
  for (int i = 0; i < KCH; ++i) { int c = tid + NTHR * i, row = c / NKC, ch = c % NKC; kgo[i] = row * ldk + ch * 8; klo[i] = row * (DK * 2) + ((ch * 16) ^ (((row >> 1) & 7) << 4)); }
#pragma unroll
  for (int i = 0; i < VCH; ++i) { int c = tid + NTHR * i, row = c / NVC, ch = c % NVC; vgo[i] = row * ldv + ch * 8; vlo[i] = v_st(row, ch * 8); }
  h8 ks[KCH], vs[VCH];
  const int kswz = ((r32 >> 1) & 7) << 4;
  const int vb0 = (int)(uintptr_t)Vl + v_rd_base(lane);
  float m_reg = NEGV, l_reg = 0.f;
#pragma unroll
  for (int d = 0; d < ND; ++d)
#pragma unroll
    for (int r = 0; r < 16; ++r) o[d][r] = 0.f;
  const int tlast = ntot - 1;
#define KLOAD(t) do { const int tt_ = (t) < tlast ? (t) : tlast; const long kb_ = kbase + 64 * tt_; _Pragma("unroll") for (int i = 0; i < KCH; ++i) ks[i] = *(const h8*)(Kp + kb_ * ldk + kgo[i]); } while (0)
#define VLOAD(t) do { const int tt_ = (t) < tlast ? (t) : tlast; const long kb_ = kbase + 64 * tt_; _Pragma("unroll") for (int i = 0; i < VCH; ++i) vs[i] = *(const h8*)(Vp + kb_ * ldv + vgo[i]); } while (0)
#define KWRITE(slot) do { _Pragma("unroll") for (int i = 0; i < KCH; ++i) *(h8*)(Kl + (slot) * KB + klo[i]) = ks[i]; } while (0)
#define VWRITE(b) do { _Pragma("unroll") for (int i = 0; i < VCH; ++i) *(h8*)(Vl + (b) * 16384 + vlo[i]) = vs[i]; } while (0)
#define QKT(S0, S1, slot) do { const char* Kc_ = Kl + (slot) * KB; \
    _Pragma("unroll") for (int r = 0; r < 16; ++r) { S0[r] = 0.f; S1[r] = 0.f; } \
    _Pragma("unroll") for (int d0 = 0; d0 < DK / 16; ++d0) { const int cb_ = (d0 * 32 + hi * 16) ^ kswz; \
      h8 b0_ = *(const h8*)(Kc_ + r32 * (DK * 2) + cb_); h8 b1_ = *(const h8*)(Kc_ + (32 + r32) * (DK * 2) + cb_); \
      S0 = mfma16(b0_, qr[d0], S0); S1 = mfma16(b1_, qr[d0], S1); } } while (0)
#define PK4(P, BASE, OUT) do { unsigned a0 = cvtpk(P[BASE + 0], P[BASE + 1]), a1 = cvtpk(P[BASE + 2], P[BASE + 3]);   \
    unsigned b0 = cvtpk(P[BASE + 4], P[BASE + 5]), b1 = cvtpk(P[BASE + 6], P[BASE + 7]);                              \
    auto r0 = __builtin_amdgcn_permlane32_swap(a0, b0, false, false); auto r1 = __builtin_amdgcn_permlane32_swap(a1, b1, false, false); \
    u32x4 w = {r0[0], r1[0], r0[1], r1[1]}; OUT = __builtin_bit_cast(h8, w); } while (0)
#define STEP(C0, C1, N0, N1, t) do { \
    KLOAD((t) + 2); VLOAD((t) + 1); \
    __builtin_amdgcn_sched_barrier(0); \
    QKT(N0, N1, s1); \
    float pm0 = fmaxf(C0[0], C0[1]), pm1 = fmaxf(C0[2], C0[3]), pm2 = fmaxf(C1[0], C1[1]), pm3 = fmaxf(C1[2], C1[3]); \
    _Pragma("unroll") for (int r = 4; r < 16; r += 4) { \
      pm0 = fmaxf(pm0, fmaxf(C0[r], C0[r + 1])); pm1 = fmaxf(pm1, fmaxf(C0[r + 2], C0[r + 3])); \
      pm2 = fmaxf(pm2, fmaxf(C1[r], C1[r + 1])); pm3 = fmaxf(pm3, fmaxf(C1[r + 2], C1[r + 3])); } \
    float pmax = fmaxf(fmaxf(pm0, pm1), fmaxf(pm2, pm3)); \
    { auto rr = __builtin_amdgcn_permlane32_swap(__float_as_uint(pmax), __float_as_uint(pmax), false, false); \
      pmax = fmaxf(__uint_as_float(rr[0]), __uint_as_float(rr[1])); } \
    const float mn = fmaxf(m_reg, pmax); \
    const float alpha = __builtin_amdgcn_exp2f(m_reg - mn); \
    m_reg = mn; \
    float ps, ps0 = 0.f, ps1 = 0.f, ps2 = 0.f, ps3 = 0.f; \
    _Pragma("unroll") for (int r = 0; r < 16; r += 2) { \
      C0[r] = __builtin_amdgcn_exp2f(C0[r] - mn); ps0 += C0[r]; C0[r + 1] = __builtin_amdgcn_exp2f(C0[r + 1] - mn); ps1 += C0[r + 1]; \
      C1[r] = __builtin_amdgcn_exp2f(C1[r] - mn); ps2 += C1[r]; C1[r + 1] = __builtin_amdgcn_exp2f(C1[r + 1] - mn); ps3 += C1[r + 1]; } \
    ps = (ps0 + ps1) + (ps2 + ps3); \
    { auto rr = __builtin_amdgcn_permlane32_swap(__float_as_uint(ps), __float_as_uint(ps), false, false); \
      ps = __uint_as_float(rr[0]) + __uint_as_float(rr[1]); } \
    l_reg = l_reg * alpha + ps; \
    h8 pa0, pa1, pa2, pa3; \
    PK4(C0, 0, pa0); PK4(C0, 8, pa1); PK4(C1, 0, pa2); PK4(C1, 8, pa3); \
    if (__any(alpha < 1.f)) { \
      if (hi == 0) wsf[r32] = alpha; \
      __builtin_amdgcn_wave_barrier(); \
      float al[16]; \
      _Pragma("unroll") for (int r = 0; r < 16; ++r) al[r] = wsf[crow(r, hi)]; \
      _Pragma("unroll") for (int d = 0; d < ND; ++d) _Pragma("unroll") for (int r = 0; r < 16; ++r) o[d][r] *= al[r]; \
      __builtin_amdgcn_wave_barrier(); \
    } \
    pv_tile<ND>(o, vb0 + ((t) & 1) * 16384, pa0, pa1, pa2, pa3); \
    KWRITE(s2); VWRITE(((t) + 1) & 1); \
    { const int s3 = 3 - s1 - s2; s1 = s2; s2 = s3; } \
    __syncthreads(); \
  } while (0)

  f32x16 pA0, pA1, pB0, pB1;
  KLOAD(0); VLOAD(0); KWRITE(0); VWRITE(0); KLOAD(1); KWRITE(1);
  __syncthreads();
  QKT(pA0, pA1, 0);
  int s1 = 1, s2 = 2;
  for (int t = 0; t < ntot; t += 2) {
    STEP(pA0, pA1, pB0, pB1, t);
    STEP(pB0, pB1, pA0, pA1, t + 1);
  }
#undef STEP
#undef PK4
#undef QKT
#undef KLOAD
#undef VLOAD
#undef KWRITE
#undef VWRITE
  l_out = l_reg; m_out = m_reg;
}

DI void row_bcast(float val, float (&out)[16], char* lds) {
  const int tid = threadIdx.x, wid = tid >> 6, lane = tid & 63, r32 = lane & 31, hi = lane >> 5;
  float* wsf = (float*)(lds + 98304) + wid * 64 + 32;
  __builtin_amdgcn_wave_barrier();
  if (hi == 0) wsf[r32] = val;
  __builtin_amdgcn_wave_barrier();
#pragma unroll
  for (int r = 0; r < 16; ++r) out[r] = wsf[crow(r, hi)];
  __builtin_amdgcn_wave_barrier();
}

template <int ND>
DI void store_y(const Params& p, f32x16 (&o)[ND], float l, int q0, int ycol, const hf* SG, int ldsg, int sgcol, char* lds) {
  const int tid = threadIdx.x, wid = tid >> 6, lane = tid & 63, r32 = lane & 31, hi = lane >> 5;
  float rl[16];
  row_bcast(1.f / l, rl, lds);
#pragma unroll
  for (int r = 0; r < 16; ++r) {
    const long row = q0 + wid * 32 + crow(r, hi);
#pragma unroll
    for (int d = 0; d < ND; ++d) {
      const int cc = d * 32 + r32;
      const float sg = (float)SG[row * ldsg + sgcol + cc];
      p.Y[row * DM + ycol + cc] = (hf)(o[d][r] * rl[r] * sg);
    }
    __builtin_amdgcn_sched_barrier(0);
  }
}

DI void phase_attn_even(const Params& p, char* lds) {
  const int tid = threadIdx.x, wid = tid >> 6, lane = tid & 63, r32 = lane & 31, hi = lane >> 5;
  const hf* PE = p.P;
  float* O1 = (float*)p.H;
  constexpr int NB = 256, NBC = 4, NA = 512, NAC = 8, NIT = NB + NBC + NA + NAC;
  const float lam = p.lam[0];
  for (int it = blockIdx.x; it < NIT; it += gridDim.x) {
    if (it < NB + NBC) {
      int hb, q0, nctx, ntot;
      if (it < NB) { hb = it >> 6; q0 = (it & 63) * 256; nctx = 0; ntot = M_ALL / 64; }
      else { hb = it - NB; q0 = S_LAT; nctx = 4; ntot = 4; }
      f32x16 o[4]; float l, m;
      attn_core<64, 128, 0>(PE + 768 + (hb * 2) * 64, IN_E, PE + 1280 + (hb * 2) * 64, IN_E, PE + 1792 + hb * 128, IN_E,
                            q0, nctx, S_LAT, 0, ntot, nullptr, o, l, m, lds);
      {
        float rl[16]; row_bcast(1.f / l, rl, lds);
#pragma unroll
        for (int r = 0; r < 16; ++r) {
          const long row = q0 + wid * 32 + crow(r, hi);
#pragma unroll
          for (int d = 0; d < 4; ++d) O1[row * 512 + hb * 128 + d * 32 + r32] = o[d][r] * rl[r];
          __builtin_amdgcn_sched_barrier(0);
        }
      }
      attn_core<64, 128, 0>(PE + 768 + (hb * 2 + 1) * 64, IN_E, PE + 1280 + (hb * 2 + 1) * 64, IN_E, PE + 1792 + hb * 128, IN_E,
                            q0, nctx, S_LAT, 0, ntot, nullptr, o, l, m, lds);
      {
        float rl[16]; row_bcast(1.f / l, rl, lds);
#pragma unroll
        for (int r = 0; r < 16; ++r) {
          const long row = q0 + wid * 32 + crow(r, hi);
          float ss = 0.f;
#pragma unroll
          for (int d = 0; d < 4; ++d) {
            const float v = O1[row * 512 + hb * 128 + d * 32 + r32] - lam * (o[d][r] * rl[r]);
            o[d][r] = v; ss += v * v;
          }
#pragma unroll
          for (int s = 16; s >= 1; s >>= 1) ss += __shfl_xor(ss, s);
          const float rstd = rsqrtf(ss * (1.f / 128.f) + EPS) * 0.8f;
#pragma unroll
          for (int d = 0; d < 4; ++d) {
            const int cc = hb * 128 + d * 32 + r32;
            const float sg = (float)PE[row * IN_E + 2304 + 512 + cc];
            p.Y[row * DM + 512 + cc] = (hf)(o[d][r] * rstd * p.ev_b_subln_g[d * 32 + r32] * sg);
          }
          __builtin_amdgcn_sched_barrier(0);
        }
      }
    } else {
      int ia = it - NB - NBC, h, q0, lb, ntot;
      if (ia < NA) {
        h = ia >> 6; q0 = (ia & 63) * 256;
        lb = q0 - 128 < 0 ? 0 : q0 - 128;
        int le = q0 + 384 > S_LAT ? S_LAT : q0 + 384;
        ntot = 4 + (le - lb) / 64;
      } else { h = ia - NA; q0 = S_LAT; lb = 0; ntot = 4; }
      f32x16 o[2]; float l, m;
      attn_core<64, 64, 1>(PE + h * 64, IN_E, PE + 512 + (h >> 2) * 64, IN_E, PE + 640 + (h >> 2) * 64, IN_E,
                           q0, 4, S_LAT, lb, ntot, nullptr, o, l, m, lds);
      l += __builtin_amdgcn_exp2f(p.ev_a_sink[h] * LOG2E - m);
      store_y<2>(p, o, l, q0, h * 64, PE, IN_E, 2304 + h * 64, lds);
    }
  }
}

DI void phase_attn_odd(const Params& p, char* lds) {
  const hf* PO = p.P; const hf* VC = p.H + (long)M_ALL * 384;
  constexpr int NC = 256, ND_ = 512;
  for (int it = blockIdx.x; it < NC + ND_; it += gridDim.x) {
    if (it < NC) {
      const int h = it >> 6, q0 = (it & 63) * 256;
      f32x16 o[4]; float l, m;
      attn_core<192, 128, 0>(p.QC + h * 192, 768, p.KC + h * 192, 768, VC + h * 128, 512, q0, 0, S_LAT, 0, M_ALL / 64, nullptr, o, l, m, lds);
      store_y<4>(p, o, l, q0, h * 128, PO, IN_OP, 1984 + h * 128, lds);
    } else {
      const int id = it - NC, h = id >> 6, q0 = (id & 63) * 256, R0 = q0 >> 6;
      int lo_r = R0 - 4; lo_r = lo_r < 0 ? 0 : (lo_r > 248 ? 248 : lo_r);
      int hi_r = R0 - 1; hi_r = hi_r < 0 ? 0 : (hi_r > 248 ? 248 : hi_r); hi_r += 7;
      f32x16 o[2]; float l, m;
      attn_core<64, 64, 2>(PO + 448 + h * 64, IN_OP, PO + 960 + h * 64, IN_OP, PO + 1472 + h * 64, IN_OP,
                           q0, 4, S_LAT, lo_r * 64, 4 + (hi_r - lo_r + 1), p.rpb2 + h * 480, o, l, m, lds);
      store_y<2>(p, o, l, q0, 512 + h * 64, PO, IN_OP, 1984 + 512 + h * 64, lds);
    }
  }
}

#define XB_TMO      128
#define XB_XCNT(j)  (256  + 64 * (j))
#define XB_XSUB(j)  (1280 + 64 * (j))
#define XB_XGEN(j)  (2304 + 64 * (j))
#define XB_TOP      3328
#define XB_TOPGEN   3392
#define XCD_BAR_WORDS 3456
#define XB_SPIN_CAP (1u << 22)
DI unsigned xb_ld(unsigned* p) { return __hip_atomic_load(p, __ATOMIC_RELAXED, __HIP_MEMORY_SCOPE_AGENT); }
DI unsigned xb_add(unsigned* p, unsigned v) { return __hip_atomic_fetch_add(p, v, __ATOMIC_RELAXED, __HIP_MEMORY_SCOPE_AGENT); }
DI unsigned xb_xcc_id() { return (unsigned)__builtin_amdgcn_s_getreg((3 << 11) | 20) & 0xFu; }
#define XB_SPIN(cond, bar) do { unsigned _sp = 0; while (cond) { __builtin_amdgcn_s_sleep(1); \
    if ((++_sp & 255u) == 0u) { if (xb_ld(&(bar)[XB_TMO])) break; if (_sp > XB_SPIN_CAP) { atomicAdd(&(bar)[XB_TMO], 1u); break; } } } } while (0)
DI void xcd_barrier_complete(unsigned* bar, unsigned x, unsigned& nloc, unsigned& nx) {
  const unsigned G = gridDim.x;
  unsigned sum, cnt, mine, sp = 0u;
  for (;;) {
    sum = 0u; cnt = 0u; mine = 0u;
#pragma unroll
    for (unsigned j = 0; j < 16; ++j) { const unsigned c = xb_ld(&bar[XB_XCNT(j)]); sum += c; cnt += (c > 0u) ? 1u : 0u; mine = (j == x) ? c : mine; }
    if (sum == G) break;
    __builtin_amdgcn_s_sleep(1);
    if ((++sp & 255u) == 0u) { if (xb_ld(&bar[XB_TMO])) break; if (sp > XB_SPIN_CAP) { atomicAdd(&bar[XB_TMO], 1u); break; } }
  }
  nloc = mine > 0u ? mine : 1u; nx = cnt > 0u ? cnt : 1u;
}
DI void grid_bar(unsigned* bar, unsigned x, volatile unsigned* st) {
  asm volatile("s_waitcnt vmcnt(0)" ::: "memory");
  __syncthreads();
  if (threadIdx.x == 0) {
    __builtin_amdgcn_s_waitcnt(0);
    unsigned nloc = st[0], nx = st[1];
    if (nloc == 0u) { xcd_barrier_complete(bar, x, nloc, nx); st[0] = nloc; st[1] = nx; }
    const unsigned old = xb_add(&bar[XB_XSUB(x)], 1u);
    const unsigned gen = old / nloc;
    if (old + 1u == (gen + 1u) * nloc) {
      __builtin_amdgcn_fence(__ATOMIC_RELEASE, "agent");
      asm volatile("s_waitcnt vmcnt(0)" ::: "memory");
      const unsigned og = xb_add(&bar[XB_TOP], 1u);
      const unsigned tg = og / nx;
      if (og + 1u == (tg + 1u) * nx) xb_add(&bar[XB_TOPGEN], 1u);
      else XB_SPIN(xb_ld(&bar[XB_TOPGEN]) == tg, bar);
      __builtin_amdgcn_fence(__ATOMIC_ACQUIRE, "agent");
      xb_add(&bar[XB_XGEN(x)], 1u);
      asm volatile("s_waitcnt vmcnt(0)" ::: "memory");
    } else {
      XB_SPIN(xb_ld(&bar[XB_XGEN(x)]) == gen, bar);
      __builtin_amdgcn_fence(__ATOMIC_ACQUIRE, "agent");
      asm volatile("s_waitcnt vmcnt(0)" ::: "memory");
    }
  }
  __syncthreads();
}

__global__ void __launch_bounds__(NTHR) fwd_megakernel(Params p) {
  __shared__ __attribute__((aligned(16))) char lds[LDS_BYTES];
  __shared__ __attribute__((aligned(16))) unsigned xb_st[4];
  cg::grid_group grid = cg::this_grid();
  if (threadIdx.x < 4) xb_st[threadIdx.x] = 0u;
  const unsigned xcc = xb_xcc_id();
  if (threadIdx.x == 0) (void)xb_add(&p.bar[XB_XCNT(xcc)], 1u);
  __syncthreads();
  phase_prep(p, lds);            grid_bar(p.bar, xcc, xb_st);
  if (__builtin_expect(p.bar == nullptr, 0)) grid.sync();
  phase_modnorm(p, 0);           grid_bar(p.bar, xcc, xb_st);
  phase_inproj_even(p, lds);     grid_bar(p.bar, xcc, xb_st);
  phase_attn_even(p, lds);       grid_bar(p.bar, xcc, xb_st);
  phase_outproj(p, 0, lds);      grid_bar(p.bar, xcc, xb_st);
  phase_modnorm(p, 1);           grid_bar(p.bar, xcc, xb_st);
  phase_inproj_odd(p, lds);      grid_bar(p.bar, xcc, xb_st);
  phase_mla_rows(p);             grid_bar(p.bar, xcc, xb_st);
  phase_mla_proj(p, lds);        grid_bar(p.bar, xcc, xb_st);
  phase_attn_odd(p, lds);        grid_bar(p.bar, xcc, xb_st);
  phase_outproj(p, 1, lds);      grid_bar(p.bar, xcc, xb_st);
  phase_final(p);
}

extern "C" void kernel_launch(void* const* d_in, const int* in_sizes, int n_in, void* d_out, int out_size, void* d_ws, size_t ws_size, hipStream_t stream) {
  static int grid_blocks = 0;
  if (!grid_blocks) {
    int dev = 0, cus = 0, per_cu = 0;
    hipGetDevice(&dev);
    hipDeviceGetAttribute(&cus, hipDeviceAttributeMultiprocessorCount, dev);
    hipOccupancyMaxActiveBlocksPerMultiprocessor(&per_cu, fwd_megakernel, NTHR, 0);
    if (per_cu < 1) per_cu = 1;
    if (per_cu > 1) per_cu = 1;
    grid_blocks = cus * per_cu;
  }
  Params p{};
  const float* const* in = (const float* const*)d_in;
  p.x = in[0]; p.c = in[1]; p.ctx = in[2]; p.c_ctx = in[3]; p.ev_norm_g = in[4]; p.ev_w_ada = in[5]; p.ev_b_ada = in[6]; p.ev_w_in = in[7];
  p.ev_a_sink = in[8]; p.ev_b_lambda = in[9]; p.ev_b_subln_g = in[10]; p.ev_w_out = in[11];
  p.od_norm_g = in[12]; p.od_w_ada = in[13]; p.od_b_ada = in[14]; p.od_w_in = in[15]; p.od_q_norm_g = in[16]; p.od_kv_norm_g = in[17];
  p.od_w_qb = in[18]; p.od_w_kvb = in[19]; p.od_rpb = in[20]; p.od_w_out = in[21]; p.final_g = in[22];
  p.out = (float*)d_out;
  char* w = (char*)d_ws; size_t off = 0;
  auto take = [&](size_t bytes) { char* r = w + off; off += (bytes + 255) & ~(size_t)255; return r; };
  p.WinE = (hf*)take((size_t)IN_E * DM * 2); p.WinO = (hf*)take((size_t)IN_OP * DM * 2);
  p.WoutE = (hf*)take((size_t)DM * DM * 2); p.WoutO = (hf*)take((size_t)DM * DM * 2);
  p.Wqb = (hf*)take((size_t)768 * 256 * 2); p.Wkvb = (hf*)take((size_t)1024 * 128 * 2);
  p.mod = (float*)take(4 * 3072 * 4); p.rope = (float*)take(10240 * 4); p.lam = (float*)take(256); p.rpb2 = (float*)take(8 * 15 * 32 * 4);
  p.H = (hf*)take((size_t)M_ALL * DM * 2);
  p.P = (hf*)take((size_t)M_ALL * IN_E * 2);
  p.Y = (hf*)take((size_t)M_ALL * DM * 2);
  p.QC = (hf*)take((size_t)M_ALL * 768 * 2); p.KC = (hf*)take((size_t)M_ALL * 768 * 2);
  p.x1ctx = (float*)take((size_t)256 * DM * 4);
  p.bar = (unsigned*)take(XCD_BAR_WORDS * 4);
  if (off > ws_size) { fprintf(stderr, "kernel_launch: workspace too small (%zu > %zu)\n", off, ws_size); return; }
  hipMemsetAsync(p.bar, 0, XCD_BAR_WORDS * 4, stream);
  void* args[] = {&p};
  hipError_t e = hipLaunchCooperativeKernel((void*)fwd_megakernel, dim3(grid_blocks), dim3(NTHR), args, 0, stream);
  if (e != hipSuccess) fprintf(stderr, "cooperative launch failed: %s (grid %d)\n", hipGetErrorString(e), grid_blocks);
}
```

```cpp
#include <hip/hip_runtime.h>
#include <hip/hip_cooperative_groups.h>
#include <cstdio>
namespace cg = cooperative_groups;

typedef __bf16 hf;
using h8 = __attribute__((ext_vector_type(8))) __bf16;
using h4 = __attribute__((ext_vector_type(4))) __bf16;
using s16x8 = __attribute__((ext_vector_type(8))) short;
using f32x16 = __attribute__((ext_vector_type(16))) float;
using f32x4 = __attribute__((ext_vector_type(4))) float;
using u32x4 = __attribute__((ext_vector_type(4))) unsigned;
using s16x4 = __attribute__((ext_vector_type(4))) short;
#define DI __device__ __forceinline__

constexpr int S_LAT = 16384, M_ALL = 16640, DM = 1024;
constexpr int IN_E = 3328, IN_O = 3008, IN_OP = 3072;
constexpr int NTHR = 512;
constexpr float LOG2E = 1.4426950408889634f;
constexpr float NEGV = -1e30f;
constexpr float EPS = 1e-6f;
constexpr int LDS_BYTES = 131072;

struct Params {
  const float *x, *c, *ctx, *c_ctx, *ev_norm_g, *ev_w_ada, *ev_b_ada, *ev_w_in, *ev_a_sink, *ev_b_lambda, *ev_b_subln_g, *ev_w_out;
  const float *od_norm_g, *od_w_ada, *od_b_ada, *od_w_in, *od_q_norm_g, *od_kv_norm_g, *od_w_qb, *od_w_kvb, *od_rpb, *od_w_out, *final_g;
  float* out;
  hf *WinE, *WinO, *WoutE, *WoutO, *Wqb, *Wkvb;
  float *mod;
  float *rope;
  float *lam;
  float *rpb2;
  hf *H;
  hf *P;
  hf *Y;
  hf *QC, *KC;
  float *x1ctx;
  unsigned *bar;
};

DI int crow(int r, int hi) { return (r & 3) + 8 * (r >> 2) + 4 * hi; }
DI float silu_f(float v) { return v * __builtin_amdgcn_rcpf(1.f + __expf(-v)); }
DI f32x16 mfma16(h8 a, h8 b, f32x16 c) { return __builtin_amdgcn_mfma_f32_32x32x16_bf16(__builtin_bit_cast(s16x8, a), __builtin_bit_cast(s16x8, b), c, 0, 0, 0); }
using bf2 = __attribute__((ext_vector_type(2))) __bf16;
DI unsigned cvtpk(float lo, float hi) { bf2 v = {(__bf16)lo, (__bf16)hi}; return __builtin_bit_cast(unsigned, v); }
DI float wave_sum(float v) {
#pragma unroll
  for (int o = 32; o >= 1; o >>= 1) v += __shfl_xor(v, o);
  return v;
}

DI void transpose_tile(const float* __restrict__ W, int K, int N, hf* __restrict__ Wt, int kt, int nt, float* lds) {
  const int tid = threadIdx.x, k0 = kt * 64, n0 = nt * 64;
#pragma unroll
  for (int i = 0; i < 8; ++i) {
    int idx = tid + NTHR * i, kk = idx >> 6, nn = idx & 63;
    lds[kk * 65 + nn] = (n0 + nn < N) ? W[(long)(k0 + kk) * N + n0 + nn] : 0.f;
  }
  __syncthreads();
#pragma unroll
  for (int i = 0; i < 8; ++i) {
    int idx = tid + NTHR * i, nn = idx >> 6, kk = idx & 63;
    Wt[(long)(n0 + nn) * K + k0 + kk] = (hf)lds[kk * 65 + nn];
  }
  __syncthreads();
}

DI void gemv_item(const Params& p, int it, float* lds) {
  const int m = it / 48, cgp = it % 48, tid = threadIdx.x, kq = tid >> 6, col = cgp * 64 + (tid & 63);
  const float* W = m ? p.od_w_ada : p.ev_w_ada;
  const float* bias = m ? p.od_b_ada : p.ev_b_ada;
  float* sc = lds + 1024;
  for (int k = tid; k < 1024; k += NTHR) { sc[k] = silu_f(p.c[k]); sc[1024 + k] = silu_f(p.c_ctx[k]); }
  __syncthreads();
  float a1 = 0.f, a2 = 0.f;
  const float* Wp = W + (long)(kq * 128) * 3072 + col;
#pragma unroll 1
  for (int k0 = 0; k0 < 128; k0 += 16) {
    float w[16];
#pragma unroll
    for (int j = 0; j < 16; ++j) w[j] = Wp[(long)(k0 + j) * 3072];
#pragma unroll
    for (int j = 0; j < 16; ++j) { a1 += sc[kq * 128 + k0 + j] * w[j]; a2 += sc[1024 + kq * 128 + k0 + j] * w[j]; }
  }
  lds[kq * 64 + (tid & 63)] = a1; lds[512 + kq * 64 + (tid & 63)] = a2;
  __syncthreads();
  if (tid < 128) {
    int which = tid >> 6, cc = tid & 63; float s = 0.f;
#pragma unroll
    for (int q = 0; q < 8; ++q) s += lds[which * 512 + q * 64 + cc];
    p.mod[(m * 2 + which) * 3072 + cgp * 64 + cc] = s + bias[cgp * 64 + cc];
  }
  __syncthreads();
}

DI void tables_item(const Params& p) {
  const int tid = threadIdx.x;
  for (int idx = tid; idx < 320 * 16; idx += NTHR) {
    int pos = idx >> 4, i = idx & 15;
    float inv = exp2f(-(float)i * (13.287712379549449f / 16.f));
    if (pos < 256) { float a = (float)pos * inv; p.rope[pos * 16 + i] = cosf(a); p.rope[4096 + pos * 16 + i] = sinf(a); }
    else { int cc = pos - 256; float a = (float)cc * inv; p.rope[8192 + cc * 16 + i] = cosf(a); p.rope[9216 + cc * 16 + i] = sinf(a); }
  }
  for (int idx = tid; idx < 8 * 15 * 32; idx += NTHR) { const int j = idx & 31, hd = idx >> 5; p.rpb2[idx] = j < 31 ? p.od_rpb[hd * 31 + j] * LOG2E : 0.f; }
  if (tid == 0) {
    float s1 = 0.f, s2 = 0.f;
    for (int i = 0; i < 64; ++i) { s1 += p.ev_b_lambda[i] * p.ev_b_lambda[64 + i]; s2 += p.ev_b_lambda[128 + i] * p.ev_b_lambda[192 + i]; }
    p.lam[0] = expf(s1) - expf(s2) + 0.2f;
  }
}

DI void transpose_big(const float* __restrict__ W, int K, int N, hf* __restrict__ Wt, int kt, int nt, float* lds) {
  int tid = threadIdx.x; asm volatile("" : "+v"(tid));
  const int k0 = kt * 64, n0 = nt * 256;
  constexpr int LD = 260;
#pragma unroll
  for (int i = 0; i < 8; ++i) {
    const int f = tid + NTHR * i, kk = f >> 6, n4 = (f & 63) * 4;
    f32x4 v = {0.f, 0.f, 0.f, 0.f};
    if (n0 + n4 < N) v = *(const f32x4*)(W + (long)(k0 + kk) * N + n0 + n4);
    *(f32x4*)(lds + kk * LD + n4) = v;
  }
  __syncthreads();
#pragma unroll
  for (int i = 0; i < 4; ++i) {
    const int c = tid + NTHR * i, nn = c >> 3, kc = (c & 7) * 8;
    h8 o;
#pragma unroll
    for (int j = 0; j < 8; ++j) o[j] = (hf)lds[(kc + j) * LD + nn];
    *(h8*)(Wt + (long)(n0 + nn) * K + k0 + kc) = o;
  }
  __syncthreads();
}

DI void phase_prep(const Params& p, char* lds) {
  float* fl = (float*)lds;
  constexpr int T0 = 97, T_WE = 16 * 13, T_WO = 16 * 12, T_OE = 16 * 4, T_OO = 16 * 4, T_QB = 4 * 3, T_KV = 2 * 4;
  constexpr int NIT = T0 + T_WE + T_WO + T_OE + T_OO + T_QB + T_KV;
  for (int it = blockIdx.x; it < NIT; it += gridDim.x) {
    if (it < 96) { gemv_item(p, it, fl); continue; }
    if (it == 96) { tables_item(p); continue; }
    int t = it - T0;
    if (t < T_WE) { transpose_big(p.ev_w_in, 1024, IN_E, p.WinE, t / 13, t % 13, fl); continue; } t -= T_WE;
    if (t < T_WO) { transpose_big(p.od_w_in, 1024, IN_O, p.WinO, t / 12, t % 12, fl); continue; } t -= T_WO;
    if (t < T_OE) { transpose_big(p.ev_w_out, 1024, 1024, p.WoutE, t / 4, t % 4, fl); continue; } t -= T_OE;
    if (t < T_OO) { transpose_big(p.od_w_out, 1024, 1024, p.WoutO, t / 4, t % 4, fl); continue; } t -= T_OO;
    if (t < T_QB) { transpose_big(p.od_w_qb, 256, 768, p.Wqb, t / 3, t % 3, fl); continue; } t -= T_QB;
    transpose_big(p.od_w_kvb, 128, 1024, p.Wkvb, t / 4, t % 4, fl);
  }
}

DI void phase_modnorm(const Params& p, int layer) {
  int tid = threadIdx.x; asm volatile("" : "+v"(tid));
  const int lane = tid & 63, gw = blockIdx.x * 8 + (tid >> 6), nw = gridDim.x * 8;
  const float* ng = layer ? p.od_norm_g : p.ev_norm_g;
  auto srcrow = [&](int row) -> const float* {
    const bool isc = row >= S_LAT;
    if (layer == 0) return isc ? p.ctx + (long)(row - S_LAT) * DM : p.x + (long)row * DM;
    return isc ? p.x1ctx + (long)(row - S_LAT) * DM : p.out + (long)row * DM;
  };
  for (int row0 = gw; row0 < M_ALL; row0 += 2 * nw) {
    const int row1 = row0 + nw; const bool has1 = row1 < M_ALL;
    const float* s0 = srcrow(row0); const float* s1 = srcrow(has1 ? row1 : row0);
    f32x4 v0[4], v1[4]; float ss0 = 0.f, ss1 = 0.f;
#pragma unroll
    for (int i = 0; i < 4; ++i) { v0[i] = *(const f32x4*)(s0 + lane * 4 + 256 * i); v1[i] = *(const f32x4*)(s1 + lane * 4 + 256 * i); }
#pragma unroll
    for (int i = 0; i < 4; ++i) {
      ss0 += v0[i][0] * v0[i][0] + v0[i][1] * v0[i][1] + v0[i][2] * v0[i][2] + v0[i][3] * v0[i][3];
      ss1 += v1[i][0] * v1[i][0] + v1[i][1] * v1[i][1] + v1[i][2] * v1[i][2] + v1[i][3] * v1[i][3];
    }
    ss0 = wave_sum(ss0); ss1 = wave_sum(ss1);
    const float rstd0 = rsqrtf(ss0 * (1.f / DM) + EPS), rstd1 = rsqrtf(ss1 * (1.f / DM) + EPS);
    const float* md0 = p.mod + (layer * 2 + (row0 >= S_LAT ? 1 : 0)) * 3072;
    const float* md1 = p.mod + (layer * 2 + (row1 >= S_LAT ? 1 : 0)) * 3072;
#pragma unroll
    for (int i = 0; i < 4; ++i) {
      const int cb = lane * 4 + 256 * i;
      const f32x4 g = *(const f32x4*)(ng + cb);
      { const f32x4 sh = *(const f32x4*)(md0 + cb), sc = *(const f32x4*)(md0 + 1024 + cb);
        h4 o;
#pragma unroll
        for (int j = 0; j < 4; ++j) o[j] = (hf)(v0[i][j] * rstd0 * g[j] * (1.f + sc[j]) + sh[j]);
        *(h4*)(p.H + (long)row0 * DM + cb) = o; }
      if (has1) {
        const f32x4 sh = *(const f32x4*)(md1 + cb), sc = *(const f32x4*)(md1 + 1024 + cb);
        h4 o;
#pragma unroll
        for (int j = 0; j < 4; ++j) o[j] = (hf)(v1[i][j] * rstd1 * g[j] * (1.f + sc[j]) + sh[j]);
        *(h4*)(p.H + (long)row1 * DM + cb) = o;
      }
    }
  }
}

DI void phase_mla_rows(const Params& p) {
  int tid = threadIdx.x; asm volatile("" : "+v"(tid));
  const int lane = tid & 63, gw = blockIdx.x * 8 + (tid >> 6), nw = gridDim.x * 8;
  hf* CQN = p.H; hf* CKVN = p.H + (long)M_ALL * 256;
  constexpr int R = 4;
  const f32x4 gq = *(const f32x4*)(p.od_q_norm_g + lane * 4);
  const float gk0 = p.od_kv_norm_g[lane * 2], gk1 = p.od_kv_norm_g[lane * 2 + 1];
  for (int row0 = gw; row0 < M_ALL; row0 += R * nw) {
    int rows[R]; bool ok[R]; h4 q4[R]; float k0[R], k1[R], kr[R], cs[R], sn[R];
#pragma unroll
    for (int u = 0; u < R; ++u) {
      const int rr = row0 + u * nw; ok[u] = rr < M_ALL; rows[u] = ok[u] ? rr : row0;
      const hf* pr = p.P + (long)rows[u] * IN_OP;
      q4[u] = *(const h4*)(pr + lane * 4);
      k0[u] = (float)pr[256 + lane * 2]; k1[u] = (float)pr[256 + lane * 2 + 1];
      kr[u] = (float)pr[384 + lane];
      const int f = lane & 15, row = rows[u];
      if (lane & 32) { cs[u] = p.rope[8192 + (row & 63) * 16 + f]; sn[u] = p.rope[9216 + (row & 63) * 16 + f]; }
      else { cs[u] = p.rope[(row >> 6) * 16 + f]; sn[u] = p.rope[4096 + (row >> 6) * 16 + f]; }
    }
#pragma unroll
    for (int u = 0; u < R; ++u) {
      const int row = rows[u];
      float qf[4], ss = 0.f;
#pragma unroll
      for (int j = 0; j < 4; ++j) { qf[j] = (float)q4[u][j]; ss += qf[j] * qf[j]; }
      ss = wave_sum(ss);
      const float rstd = rsqrtf(ss * (1.f / 256.f) + EPS);
      const float s2 = wave_sum(k0[u] * k0[u] + k1[u] * k1[u]);
      const float rs2 = rsqrtf(s2 * (1.f / 128.f) + EPS);
      float krv = kr[u];
      const float pt = __shfl_xor(krv, 16);
      if (row < S_LAT) krv = krv * cs[u] + ((lane & 16) ? pt : -pt) * sn[u];
      if (ok[u]) {
        h4 o4;
#pragma unroll
        for (int j = 0; j < 4; ++j) o4[j] = (hf)(qf[j] * rstd * gq[j]);
        *(h4*)(CQN + (long)row * 256 + lane * 4) = o4;
        CKVN[(long)row * 128 + lane * 2] = (hf)(k0[u] * rs2 * gk0);
        CKVN[(long)row * 128 + lane * 2 + 1] = (hf)(k1[u] * rs2 * gk1);
        const hf kh = (hf)krv;
#pragma unroll
        for (int h = 0; h < 4; ++h) p.KC[(long)row * 768 + h * 192 + 128 + lane] = kh;
      }
    }
  }
}

DI void phase_final(const Params& p) {
  int tid = threadIdx.x; asm volatile("" : "+v"(tid));
  const int lane = tid & 63, gw = blockIdx.x * 8 + (tid >> 6), nw = gridDim.x * 8;
  for (int row0 = gw; row0 < S_LAT; row0 += 2 * nw) {
    const int row1 = row0 + nw; const bool has1 = row1 < S_LAT;
    float* s0 = p.out + (long)row0 * DM; float* s1 = p.out + (long)(has1 ? row1 : row0) * DM;
    f32x4 v0[4], v1[4]; float ss0 = 0.f, ss1 = 0.f;
#pragma unroll
    for (int i = 0; i < 4; ++i) { v0[i] = *(const f32x4*)(s0 + lane * 4 + 256 * i); v1[i] = *(const f32x4*)(s1 + lane * 4 + 256 * i); }
#pragma unroll
    for (int i = 0; i < 4; ++i) {
      ss0 += v0[i][0] * v0[i][0] + v0[i][1] * v0[i][1] + v0[i][2] * v0[i][2] + v0[i][3] * v0[i][3];
      ss1 += v1[i][0] * v1[i][0] + v1[i][1] * v1[i][1] + v1[i][2] * v1[i][2] + v1[i][3] * v1[i][3];
    }
    ss0 = wave_sum(ss0); ss1 = wave_sum(ss1);
    const float rstd0 = rsqrtf(ss0 * (1.f / DM) + EPS), rstd1 = rsqrtf(ss1 * (1.f / DM) + EPS);
#pragma unroll
    for (int i = 0; i < 4; ++i) {
      const int cb = lane * 4 + 256 * i;
      const f32x4 g = *(const f32x4*)(p.final_g + cb);
      f32x4 o0, o1;
#pragma unroll
      for (int j = 0; j < 4; ++j) { o0[j] = v0[i][j] * rstd0 * g[j]; o1[j] = v1[i][j] * rstd1 * g[j]; }
      *(f32x4*)(s0 + cb) = o0;
      if (has1) *(f32x4*)(s1 + cb) = o1;
    }
  }
}

template <bool TRANS, int TM, int TN, class Epi>
DI void gemm_tile(const hf* __restrict__ A, int lda, const hf* __restrict__ Bt, int ldb, int K, int m0, int n0, char* lds, Epi&& epi) {
  int tid = threadIdx.x; asm volatile("" : "+v"(tid));
  const int wid = __builtin_amdgcn_readfirstlane(tid >> 6), lane = tid & 63, r32 = lane & 31, hi = lane >> 5;
  const int wm = wid >> 1, wn = wid & 1;
  constexpr int ACH = 128 * TM * 8 / NTHR, BCH = 64 * TN * 8 / NTHR;
  char* As = lds; char* Bs = lds + 65536;
  const hf* Ag[ACH]; const hf* Bg[BCH]; int loa[ACH], lob[BCH];
#pragma unroll
  for (int i = 0; i < ACH; ++i) {
    int c = tid + NTHR * i, row = c >> 3, ch = c & 7;
    loa[i] = row * 128 + ((ch ^ ((row >> 1) & 7)) << 4);
    Ag[i] = A + (long)(m0 + row) * lda + ch * 8;
  }
#pragma unroll
  for (int i = 0; i < BCH; ++i) {
    int c = tid + NTHR * i, row = c >> 3, ch = c & 7;
    lob[i] = row * 128 + ((ch ^ ((row >> 1) & 7)) << 4);
    Bg[i] = Bt + (long)(n0 + row) * ldb + ch * 8;
  }
  f32x16 acc[TM][TN];
#pragma unroll
  for (int a = 0; a < TM; ++a)
#pragma unroll
    for (int b = 0; b < TN; ++b)
#pragma unroll
      for (int r = 0; r < 16; ++r) acc[a][b][r] = 0.f;
  h8 ra[ACH], rb[BCH];
#pragma unroll
  for (int i = 0; i < ACH; ++i) ra[i] = *(const h8*)(Ag[i]);
#pragma unroll
  for (int i = 0; i < BCH; ++i) rb[i] = *(const h8*)(Bg[i]);
#pragma unroll
  for (int i = 0; i < ACH; ++i) *(h8*)(As + loa[i]) = ra[i];
#pragma unroll
  for (int i = 0; i < BCH; ++i) *(h8*)(Bs + lob[i]) = rb[i];
  __syncthreads();
  const int nk = K >> 6;
  const int swz = (r32 >> 1) & 7;
  for (int kt = 0; kt < nk; ++kt) {
    const int cur = kt & 1;
    if (kt + 1 < nk) {
#pragma unroll
      for (int i = 0; i < ACH; ++i) ra[i] = *(const h8*)(Ag[i] + (kt + 1) * 64);
#pragma unroll
      for (int i = 0; i < BCH; ++i) rb[i] = *(const h8*)(Bg[i] + (kt + 1) * 64);
    }
    __builtin_amdgcn_sched_barrier(0);
    const char* Ac = As + cur * 32768; const char* Bc = Bs + cur * 32768;
#pragma unroll
    for (int ks = 0; ks < 4; ++ks) {
      const int chs = ((2 * ks + hi) ^ swz) << 4;
      h8 a[TM], b[TN];
#pragma unroll
      for (int tm = 0; tm < TM; ++tm) a[tm] = *(const h8*)(Ac + (wm * (32 * TM) + tm * 32 + r32) * 128 + chs);
#pragma unroll
      for (int tn = 0; tn < TN; ++tn) b[tn] = *(const h8*)(Bc + (wn * (32 * TN) + tn * 32 + r32) * 128 + chs);
#pragma unroll
      for (int tm = 0; tm < TM; ++tm)
#pragma unroll
        for (int tn = 0; tn < TN; ++tn) acc[tm][tn] = TRANS ? mfma16(b[tn], a[tm], acc[tm][tn]) : mfma16(a[tm], b[tn], acc[tm][tn]);
    }
    __builtin_amdgcn_sched_barrier(0);
    if (kt + 1 < nk) {
#pragma unroll
      for (int i = 0; i < ACH; ++i) *(h8*)(As + (cur ^ 1) * 32768 + loa[i]) = ra[i];
#pragma unroll
      for (int i = 0; i < BCH; ++i) *(h8*)(Bs + (cur ^ 1) * 32768 + lob[i]) = rb[i];
    }
    __syncthreads();
  }
#pragma unroll
  for (int tm = 0; tm < TM; ++tm)
#pragma unroll
    for (int tn = 0; tn < TN; ++tn) { epi(m0 + wm * (32 * TM) + tm * 32, n0 + wn * (32 * TN) + tn * 32, acc[tm][tn], r32, hi); __builtin_amdgcn_sched_barrier(0); }
}

using f32x4v = __attribute__((ext_vector_type(4))) float;
DI int p8_lds_byte(int r, int c) {
  int st = (r >> 4) * 2 + (c >> 5), rr = r & 15, cc = c & 31, ob = rr * 64 + cc * 2;
  return st * 1024 + (ob ^ (((ob >> 9) & 1) << 5));
}
DI void p8_stage_rc(int b, int& R, int& C) {
  int st = b / 1024, sb = b % 1024, swz = sb ^ (((sb >> 9) & 1) << 5);
  R = (st >> 1) * 16 + swz / 64; C = (st & 1) * 32 + (swz % 64) / 2;
}
template <class Epi>
DI void gemm_tile_8p(const hf* __restrict__ A, const hf* __restrict__ Bt, int K, int brow, int bcol, char* lds, Epi&& epi) {
  constexpr int BK = 64, HALF = 128, HT = HALF * BK;
  hf* shm = (hf*)lds;
  int tid = threadIdx.x; asm volatile("" : "+v"(tid));
#define SA(b, h) (shm + ((b) * 2 + (h)) * HT)
#define SB(b, h) (shm + (4 + (b) * 2 + (h)) * HT)
#define STAGE(P, BASE, br, kt) do { long _g = (long)(br) * K + (long)(kt) * BK; \
    _Pragma("unroll") for (int _i = 0; _i < 2; ++_i) { int _b = tid * 16 + _i * 8192; int _r, _c; p8_stage_rc(_b, _r, _c); \
      __builtin_amdgcn_global_load_lds((const __attribute__((address_space(1))) unsigned*)(BASE + _g + (long)_r * K + _c), \
        (__attribute__((address_space(3))) unsigned*)((char*)(P) + _b), 16, 0, 0); } } while (0)
#define LDA(dst, b, h) _Pragma("unroll") for (int m = 0; m < 4; ++m) _Pragma("unroll") for (int k = 0; k < 2; ++k) \
    dst[m][k] = *reinterpret_cast<const h8*>((char*)SA(b, h) + p8_lds_byte(wr * 64 + m * 16 + fr, k * 32 + fq * 8))
#define LDB(dst, b, h) _Pragma("unroll") for (int n = 0; n < 2; ++n) _Pragma("unroll") for (int k = 0; k < 2; ++k) \
    dst[n][k] = *reinterpret_cast<const h8*>((char*)SB(b, h) + p8_lds_byte(wc * 32 + n * 16 + fr, k * 32 + fq * 8))
#define MMA(ai, bj, At_, Bt_) do { __builtin_amdgcn_s_setprio(1); \
    _Pragma("unroll") for (int m = 0; m < 4; ++m) _Pragma("unroll") for (int n = 0; n < 2; ++n) _Pragma("unroll") for (int k = 0; k < 2; ++k) \
      acc[ai][bj][m][n] = __builtin_amdgcn_mfma_f32_16x16x32_bf16(__builtin_bit_cast(s16x8, At_[m][k]), __builtin_bit_cast(s16x8, Bt_[n][k]), acc[ai][bj][m][n], 0, 0, 0); \
    __builtin_amdgcn_s_setprio(0); } while (0)
#define WAIT_V(n) asm volatile("s_waitcnt vmcnt(" #n ")" ::: "memory")
#define WAIT_L(n) asm volatile("s_waitcnt lgkmcnt(" #n ")" ::: "memory")
#define BAR __builtin_amdgcn_s_barrier()
#define SCHED __builtin_amdgcn_sched_barrier(0)
  const int wid = __builtin_amdgcn_readfirstlane(tid >> 6), lane = tid & 63, wr = wid >> 2, wc = wid & 3, fr = lane & 15, fq = lane >> 4;
  f32x4v acc[2][2][4][2];
#pragma unroll
  for (int a = 0; a < 2; ++a)
#pragma unroll
    for (int b = 0; b < 2; ++b)
#pragma unroll
      for (int m = 0; m < 4; ++m)
#pragma unroll
        for (int n = 0; n < 2; ++n) acc[a][b][m][n] = f32x4v{0.f, 0.f, 0.f, 0.f};
  h8 At[4][2], B0[2][2], B1[2][2];
  const int nt = K / BK;
  STAGE(SB(0, 0), Bt, bcol, 0); STAGE(SA(0, 0), A, brow, 0);
  STAGE(SB(0, 1), Bt, bcol + HALF, 0); STAGE(SA(0, 1), A, brow + HALF, 0);
  if (wr == 1) BAR;
  WAIT_V(4); BAR;
  STAGE(SB(1, 0), Bt, bcol, 1); STAGE(SA(1, 0), A, brow, 1); STAGE(SB(1, 1), Bt, bcol + HALF, 1);
  WAIT_V(6); BAR;
  for (int t = 0; t < nt - 2; t += 2) {
    LDB(B0, 0, 0); SCHED; LDA(At, 0, 0); STAGE(SA(1, 1), A, brow + HALF, t + 1);
    WAIT_L(8); BAR; WAIT_L(0); MMA(0, 0, At, B0); BAR; SCHED;
    LDB(B1, 0, 1); STAGE(SB(0, 0), Bt, bcol, t + 2);
    BAR; WAIT_L(0); MMA(0, 1, At, B1); BAR;
    LDA(At, 0, 1); STAGE(SA(0, 0), A, brow, t + 2);
    BAR; WAIT_L(0); MMA(1, 0, At, B0); BAR; SCHED;
    STAGE(SB(0, 1), Bt, bcol + HALF, t + 2);
    WAIT_V(6); BAR; MMA(1, 1, At, B1); BAR;
    LDB(B0, 1, 0); SCHED; LDA(At, 1, 0); STAGE(SA(0, 1), A, brow + HALF, t + 2);
    WAIT_L(8); BAR; WAIT_L(0); MMA(0, 0, At, B0); BAR; SCHED;
    LDB(B1, 1, 1); STAGE(SB(1, 0), Bt, bcol, t + 3);
    BAR; WAIT_L(0); MMA(0, 1, At, B1); BAR;
    LDA(At, 1, 1); STAGE(SA(1, 0), A, brow, t + 3);
    BAR; WAIT_L(0); MMA(1, 0, At, B0); BAR; SCHED;
    STAGE(SB(1, 1), Bt, bcol + HALF, t + 3);
    WAIT_V(6); BAR; MMA(1, 1, At, B1); BAR;
  }
  { LDB(B0, 0, 0); LDA(At, 0, 0); STAGE(SA(1, 1), A, brow + HALF, nt - 1);
    BAR; WAIT_L(0); MMA(0, 0, At, B0); BAR;
    LDB(B1, 0, 1); BAR; WAIT_L(0); MMA(0, 1, At, B1); BAR;
    LDA(At, 0, 1); WAIT_V(4); BAR; WAIT_L(0); MMA(1, 0, At, B0); MMA(1, 1, At, B1); BAR; }
  { LDB(B0, 1, 0); LDA(At, 1, 0); WAIT_V(2); BAR; WAIT_L(0); MMA(0, 0, At, B0); BAR;
    LDB(B1, 1, 1); WAIT_V(0); BAR; WAIT_L(0); MMA(0, 1, At, B1); BAR;
    LDA(At, 1, 1); BAR; WAIT_L(0); MMA(1, 0, At, B0); MMA(1, 1, At, B1); BAR; }
  if (wr == 0) BAR;
#pragma unroll
  for (int ai = 0; ai < 2; ++ai)
#pragma unroll
    for (int bj = 0; bj < 2; ++bj) { epi(brow + ai * HALF + wr * 64, bcol + bj * HALF + wc * 32, acc[ai][bj], fr, fq); SCHED; }
  __syncthreads();
#undef SA
#undef SB
#undef STAGE
#undef LDA
#undef LDB
#undef MMA
#undef WAIT_V
#undef WAIT_L
#undef BAR
#undef SCHED
}

DI void raster(int v, int MT, int NT, int& mt, int& nt) {
  const int grp = v / (8 * NT), fm = grp * 8, rows = (MT - fm) < 8 ? (MT - fm) : 8, r = v - grp * 8 * NT;
  mt = fm + r % rows; nt = r / rows;
}
template <bool TRANS, class Epi>
DI void gemm_phase(const hf* __restrict__ A, int lda, const hf* __restrict__ Bt, int ldb, int K, int MT, int NT, char* lds, Epi&& epi) {
  const int T = MT * NT, G = gridDim.x, full = (T / G) * G;
  for (int base = 0; base < full; base += G) {
    int v;
    if ((G & 7) == 0) v = base + (blockIdx.x & 7) * (G >> 3) + (blockIdx.x >> 3); else v = base + blockIdx.x;
    int mt, nt; raster(v, MT, NT, mt, nt);
    gemm_tile<TRANS, 2, 4>(A, lda, Bt, ldb, K, mt * 256, nt * 256, lds, epi);
  }
  const int R4 = (T - full) * 4;
  for (int q = blockIdx.x; q < R4; q += G) {
    int mt, nt; raster(full + (q >> 2), MT, NT, mt, nt);
    gemm_tile<TRANS, 1, 2>(A, lda, Bt, ldb, K, mt * 256 + ((q >> 1) & 1) * 128, nt * 256 + (q & 1) * 128, lds, epi);
  }
}

template <bool TRANS, class Epi8, class EpiQ>
DI void gemm_phase8(const hf* __restrict__ A, const hf* __restrict__ Bt, int K, int MT, int NT, char* lds, Epi8&& epi8, EpiQ&& epiq) {
  const int T = MT * NT, G = gridDim.x, full = (T / G) * G;
  for (int base = 0; base < full; base += G) {
    int v;
    if ((G & 7) == 0) v = base + (blockIdx.x & 7) * (G >> 3) + (blockIdx.x >> 3); else v = base + blockIdx.x;
    int mt, nt; raster(v, MT, NT, mt, nt);
    if (TRANS) gemm_tile_8p(Bt, A, K, nt * 256, mt * 256, lds, epi8);
    else gemm_tile_8p(A, Bt, K, mt * 256, nt * 256, lds, epi8);
  }
  const int R4 = (T - full) * 4;
  for (int q = blockIdx.x; q < R4; q += G) {
    int mt, nt; raster(full + (q >> 2), MT, NT, mt, nt);
    gemm_tile<TRANS, 1, 2>(A, K, Bt, K, K, mt * 256 + ((q >> 1) & 1) * 128, nt * 256 + (q & 1) * 128, lds, epiq);
  }
}
DI void rope_blk8(const Params& p, float (&v)[4][4], int tok, int fq) {
  const float* cr = p.rope + (tok >> 6) * 16 + fq * 4;
  const float* cc = p.rope + 8192 + (tok & 63) * 16 + fq * 4;
  const f32x4 c0 = *(const f32x4*)cr, s0 = *(const f32x4*)(cr + 4096), c1 = *(const f32x4*)cc, s1 = *(const f32x4*)(cc + 1024);
#pragma unroll
  for (int j = 0; j < 4; ++j) {
    { const float a = v[0][j], b = v[1][j]; v[0][j] = a * c0[j] - b * s0[j]; v[1][j] = b * c0[j] + a * s0[j]; }
    { const float a = v[2][j], b = v[3][j]; v[2][j] = a * c1[j] - b * s1[j]; v[3][j] = b * c1[j] + a * s1[j]; }
  }
}
DI void store_blk8(hf* base, const float (&v)[4][4], int fq) {
#pragma unroll
  for (int m = 0; m < 4; ++m) {
    h4 o = {(hf)v[m][0], (hf)v[m][1], (hf)v[m][2], (hf)v[m][3]};
    *(h4*)(base + m * 16 + fq * 4) = o;
  }
}

DI void rope_tile(const Params& p, float (&v)[16], int tok, int cb, int hi) {
  const float* ct = (cb & 32) ? p.rope + 8192 + (tok & 63) * 16 : p.rope + (tok >> 6) * 16;
  const float* st = (cb & 32) ? ct + 1024 : ct + 4096;
  const f32x4 c0 = *(const f32x4*)(ct + 4 * hi), c1 = *(const f32x4*)(ct + 8 + 4 * hi);
  const f32x4 s0 = *(const f32x4*)(st + 4 * hi), s1 = *(const f32x4*)(st + 8 + 4 * hi);
#pragma unroll
  for (int j = 0; j < 4; ++j) {
    { const float a = v[j], b = v[j + 8]; v[j] = a * c0[j] - b * s0[j]; v[j + 8] = b * c0[j] + a * s0[j]; }
    { const float a = v[4 + j], b = v[12 + j]; v[4 + j] = a * c1[j] - b * s1[j]; v[12 + j] = b * c1[j] + a * s1[j]; }
  }
}
DI void store_tile_h(hf* base, const float (&v)[16], int hi) {
#pragma unroll
  for (int g = 0; g < 4; ++g) {
    h4 o = {(hf)v[4 * g], (hf)v[4 * g + 1], (hf)v[4 * g + 2], (hf)v[4 * g + 3]};
    *(h4*)(base + 8 * g + 4 * hi) = o;
  }
}

DI void phase_inproj_even(const Params& p, char* lds) {
  constexpr int NT = IN_E / 256, MT = M_ALL / 256;
  const float qs = 0.125f * LOG2E;
  {
    gemm_phase8<true>(p.H, p.WinE, DM, MT, NT, lds, [&](int fb, int tb, f32x4v (&q)[4][2], int fr, int fq) {
      int kind;
      if (fb < 512) kind = 2; else if (fb < 640) kind = 1; else if (fb < 768) kind = 0; else if (fb < 1280) kind = 2;
      else if (fb < 1792) kind = 1; else if (fb < 2304) kind = 0; else kind = 3;
#pragma unroll
      for (int n = 0; n < 2; ++n) {
        const int tok = tb + n * 16 + fr;
        float v[4][4];
#pragma unroll
        for (int m = 0; m < 4; ++m)
#pragma unroll
          for (int j = 0; j < 4; ++j) v[m][j] = q[m][n][j];
        if ((kind == 1 || kind == 2) && tb < S_LAT) rope_blk8(p, v, tok, fq);
        if (kind == 2) {
#pragma unroll
          for (int m = 0; m < 4; ++m)
#pragma unroll
            for (int j = 0; j < 4; ++j) v[m][j] *= qs;
        } else if (kind == 3) {
#pragma unroll
          for (int m = 0; m < 4; ++m)
#pragma unroll
            for (int j = 0; j < 4; ++j) v[m][j] = silu_f(v[m][j]);
        }
        store_blk8(p.P + (size_t)tok * IN_E + fb, v, fq);
      }
    }, [&](int rb, int cb, const f32x16& acc, int r32, int hi) {
      int kind;
      if (cb < 512) kind = 2; else if (cb < 640) kind = 1; else if (cb < 768) kind = 0; else if (cb < 1280) kind = 2;
      else if (cb < 1792) kind = 1; else if (cb < 2304) kind = 0; else kind = 3;
      const int tok = rb + r32;
      float v[16];
#pragma unroll
      for (int i = 0; i < 16; ++i) v[i] = acc[i];
      if ((kind == 1 || kind == 2) && rb < S_LAT) rope_tile(p, v, tok, cb, hi);
      if (kind == 2) {
#pragma unroll
        for (int i = 0; i < 16; ++i) v[i] *= qs;
      } else if (kind == 3) {
#pragma unroll
        for (int i = 0; i < 16; ++i) v[i] = silu_f(v[i]);
      }
      store_tile_h(p.P + (size_t)tok * IN_E + cb, v, hi);
    });
  }
}

DI void phase_inproj_odd(const Params& p, char* lds) {
  constexpr int NT = IN_OP / 256, MT = M_ALL / 256;
  const float qs = 0.125f * LOG2E;
  {
    gemm_phase8<true>(p.H, p.WinO, DM, MT, NT, lds, [&](int fb, int tb, f32x4v (&q)[4][2], int fr, int fq) {
      if (fb >= IN_O) return;
      const int kind = (fb >= 1984) ? 3 : ((fb >= 448 && fb < 960) ? 2 : 0);
#pragma unroll
      for (int n = 0; n < 2; ++n) {
        const int tok = tb + n * 16 + fr;
        float v[4][4];
#pragma unroll
        for (int m = 0; m < 4; ++m)
#pragma unroll
          for (int j = 0; j < 4; ++j) v[m][j] = q[m][n][j];
        if (kind == 2) {
#pragma unroll
          for (int m = 0; m < 4; ++m)
#pragma unroll
            for (int j = 0; j < 4; ++j) v[m][j] *= qs;
        } else if (kind == 3) {
#pragma unroll
          for (int m = 0; m < 4; ++m)
#pragma unroll
            for (int j = 0; j < 4; ++j) v[m][j] = silu_f(v[m][j]);
        }
        store_blk8(p.P + (size_t)tok * IN_OP + fb, v, fq);
      }
    }, [&](int rb, int cb, const f32x16& acc, int r32, int hi) {
      if (cb >= IN_O) return;
      const int kind = (cb >= 1984) ? 3 : ((cb >= 448 && cb < 960) ? 2 : 0);
      const int tok = rb + r32;
      float v[16];
#pragma unroll
      for (int i = 0; i < 16; ++i) v[i] = acc[i];
      if (kind == 2) {
#pragma unroll
        for (int i = 0; i < 16; ++i) v[i] *= qs;
      } else if (kind == 3) {
#pragma unroll
        for (int i = 0; i < 16; ++i) v[i] = silu_f(v[i]);
      }
      store_tile_h(p.P + (size_t)tok * IN_OP + cb, v, hi);
    });
  }
}

DI void phase_mla_proj(const Params& p, char* lds) {
  constexpr int MT = M_ALL / 256;
  const hf* CQN = p.H; const hf* CKVN = p.H + (long)M_ALL * 256; hf* VC = p.H + (long)M_ALL * 384;
  const float qs = 0.07216878364870322f * LOG2E;
  gemm_phase8<true>(CQN, p.Wqb, 256, MT, 3, lds, [&](int fb, int tb, f32x4v (&q)[4][2], int fr, int fq) {
    const bool pe = (fb % 192) >= 128;
#pragma unroll
    for (int n = 0; n < 2; ++n) {
      const int tok = tb + n * 16 + fr;
      float v[4][4];
#pragma unroll
      for (int m = 0; m < 4; ++m)
#pragma unroll
        for (int j = 0; j < 4; ++j) v[m][j] = q[m][n][j];
      if (pe && tb < S_LAT) rope_blk8(p, v, tok, fq);
#pragma unroll
      for (int m = 0; m < 4; ++m)
#pragma unroll
        for (int j = 0; j < 4; ++j) v[m][j] *= qs;
      store_blk8(p.QC + (size_t)tok * 768 + fb, v, fq);
    }
  }, [&](int rb, int cb, const f32x16& acc, int r32, int hi) {
    const bool pe = (cb % 192) >= 128;
    const int tok = rb + r32;
    float v[16];
#pragma unroll
    for (int i = 0; i < 16; ++i) v[i] = acc[i];
    if (pe && rb < S_LAT) rope_tile(p, v, tok, cb, hi);
#pragma unroll
    for (int i = 0; i < 16; ++i) v[i] *= qs;
    store_tile_h(p.QC + (size_t)tok * 768 + cb, v, hi);
  });
  gemm_phase<true>(CKVN, 128, p.Wkvb, 128, 128, MT, 4, lds, [&](int rb, int cb, const f32x16& acc, int r32, int hi) {
    const int h = cb >> 8, w = cb & 255;
    const int tok = rb + r32;
    float v[16];
#pragma unroll
    for (int i = 0; i < 16; ++i) v[i] = acc[i];
    if (w < 128) store_tile_h(p.KC + (size_t)tok * 768 + h * 192 + w, v, hi);
    else store_tile_h(VC + (size_t)tok * 512 + h * 128 + (w - 128), v, hi);
  });
}

DI void phase_outproj(const Params& p, int layer, char* lds) {
  const int MT = layer ? S_LAT / 256 : M_ALL / 256;
  const hf* W = layer ? p.WoutO : p.WoutE;
  {
    gemm_phase8<false>(p.Y, W, DM, MT, 4, lds, [&](int rb, int cb, f32x4v (&q)[4][2], int fr, int fq) {
      const bool isc = rb >= S_LAT;
#pragma unroll
      for (int n = 0; n < 2; ++n) {
        const int col = cb + n * 16 + fr;
        const float g = p.mod[(layer * 2 + (isc ? 1 : 0)) * 3072 + 2048 + col];
        const float* src; float* dst;
        if (layer == 0) { if (isc) { src = p.ctx + (size_t)(rb - S_LAT) * DM + col; dst = p.x1ctx + (size_t)(rb - S_LAT) * DM + col; }
                          else { src = p.x + (size_t)rb * DM + col; dst = p.out + (size_t)rb * DM + col; } }
        else { src = p.out + (size_t)rb * DM + col; dst = p.out + (size_t)rb * DM + col; }
#pragma unroll
        for (int m = 0; m < 4; ++m)
#pragma unroll
          for (int j = 0; j < 4; ++j) { const int ro = (m * 16 + fq * 4 + j) * DM; dst[ro] = src[ro] + g * q[m][n][j]; }
      }
    }, [&](int rb, int cb, const f32x16& acc, int r32, int hi) {
      const bool isc = rb >= S_LAT;
      const int col = cb + r32;
      const float g = p.mod[(layer * 2 + (isc ? 1 : 0)) * 3072 + 2048 + col];
      const float* src; float* dst;
      if (layer == 0) { if (isc) { src = p.ctx + (size_t)(rb - S_LAT) * DM + col; dst = p.x1ctx + (size_t)(rb - S_LAT) * DM + col; }
                        else { src = p.x + (size_t)rb * DM + col; dst = p.out + (size_t)rb * DM + col; } }
      else { src = p.out + (size_t)rb * DM + col; dst = p.out + (size_t)rb * DM + col; }
#pragma unroll
      for (int i = 0; i < 16; ++i) { const int ro = crow(i, hi) * DM; dst[ro] = src[ro] + g * acc[i]; }
    });
  }
}

DI int v_st(int k, int c) { const int kk = (k & ~0xC) | ((k & 4) << 1) | ((k & 8) >> 1); return ((kk >> 3) * 4 + (c >> 5)) * 512 + ((kk & 7) * 32 + (c & 31)) * 2; }
DI int v_rd_base(int lane) { return ((lane & 3) << 3) | (((lane >> 2) & 3) << 6) | (((lane >> 4) & 1) << 5) | (((lane >> 5) & 1) << 8); }
constexpr int v_rd_off(int d0, int ks, int half) { return d0 * 512 + ks * 4096 + half * 2048; }
template <int OFF> DI s16x4 tr_read(int vb) {
  s16x4 r; asm volatile("ds_read_b64_tr_b16 %0, %1 offset:%2" : "=&v"(r) : "v"(vb), "i"(OFF) : "memory"); return r;
}
DI h8 pk8(s16x4 l, s16x4 h) {
  using s16x8 = __attribute__((ext_vector_type(8))) short;
  s16x8 v = {l[0], l[1], l[2], l[3], h[0], h[1], h[2], h[3]};
  return __builtin_bit_cast(h8, v);
}
template <int D0> DI void pv_reads(int vb, s16x4 (&r)[8]) {
  r[0] = tr_read<v_rd_off(D0, 0, 0)>(vb); r[1] = tr_read<v_rd_off(D0, 0, 1)>(vb); r[2] = tr_read<v_rd_off(D0, 1, 0)>(vb); r[3] = tr_read<v_rd_off(D0, 1, 1)>(vb);
  r[4] = tr_read<v_rd_off(D0, 2, 0)>(vb); r[5] = tr_read<v_rd_off(D0, 2, 1)>(vb); r[6] = tr_read<v_rd_off(D0, 3, 0)>(vb); r[7] = tr_read<v_rd_off(D0, 3, 1)>(vb);
}
DI void pv_mfma(f32x16& od, const s16x4 (&r)[8], h8 pa0, h8 pa1, h8 pa2, h8 pa3) {
  od = mfma16(pa0, pk8(r[0], r[1]), od);
  od = mfma16(pa1, pk8(r[2], r[3]), od);
  od = mfma16(pa2, pk8(r[4], r[5]), od);
  od = mfma16(pa3, pk8(r[6], r[7]), od);
}
#define LGKM_WAIT(n) do { asm volatile("s_waitcnt lgkmcnt(" #n ")" ::: "memory"); __builtin_amdgcn_sched_barrier(0); } while (0)
template <int ND> DI void pv_tile(f32x16 (&o)[ND], int vb, h8 pa0, h8 pa1, h8 pa2, h8 pa3) {
  s16x4 ra[8], rb[8];
  __builtin_amdgcn_sched_barrier(0);
  pv_reads<0>(vb, ra); pv_reads<1>(vb, rb);
  LGKM_WAIT(8); pv_mfma(o[0], ra, pa0, pa1, pa2, pa3);
  if constexpr (ND > 2) {
    __builtin_amdgcn_sched_barrier(0);
    pv_reads<2>(vb, ra);
    LGKM_WAIT(8); pv_mfma(o[1], rb, pa0, pa1, pa2, pa3);
    __builtin_amdgcn_sched_barrier(0);
    pv_reads<3>(vb, rb);
    LGKM_WAIT(8); pv_mfma(o[2], ra, pa0, pa1, pa2, pa3);
    LGKM_WAIT(0); pv_mfma(o[3], rb, pa0, pa1, pa2, pa3);
  } else {
    LGKM_WAIT(0); pv_mfma(o[1], rb, pa0, pa1, pa2, pa3);
  }
  __builtin_amdgcn_sched_barrier(0);
}

template <int DK, int DV, int MODE>
DI void attn_core(const hf* __restrict__ Qp, int ldq, const hf* __restrict__ Kp, int ldk, const hf* __restrict__ Vp, int ldv,
                  int q0, int nctx, int ctx_base, int loc_base, int ntot, const float* __restrict__ rpb_h,
                  f32x16 (&o)[DV / 32], float& l_out, float& m_out, char* lds) {
  int tid = threadIdx.x; asm volatile("" : "+v"(tid));
  const int wid = __builtin_amdgcn_readfirstlane(tid >> 6), lane = tid & 63, r32 = lane & 31, hi = lane >> 5;
  constexpr int KB = 64 * DK * 2, NKC = DK / 8, KCH = 64 * NKC / NTHR, NVC = DV / 8, VCH = 64 * NVC / NTHR;
  constexpr int ND = DV / 32;
  char* Vl = lds; char* Kl = lds + 49152; float* wsf = (float*)(lds + 98304) + wid * 64;
  constexpr int grp = 0;
  h8 qr[DK / 16];
  {
    const hf* Qw = Qp + (long)(q0 + wid * 32 + r32) * ldq + hi * 8;
#pragma unroll
    for (int d0 = 0; d0 < DK / 16; ++d0) qr[d0] = *(const h8*)(Qw + d0 * 16);
  }
  int kgo[KCH], klo[KCH], vgo[VCH], vlo[VCH];
#pragma unroll
  for (int i = 0; i < KCH; ++i) { int c = tid + NTHR * i, row = c / NKC, ch = c % NKC; kgo[i] = row * ldk + ch * 8; klo[i] = row * (DK * 2) + ((ch * 16) ^ (((row >> 1) & 7) << 4)); }
#pragma unroll
  for (int i = 0; i < VCH; ++i) { int c = tid + NTHR * i, row = c / NVC, ch = c % NVC; vgo[i] = row * ldv + ch * 8; vlo[i] = v_st(row, ch * 8); }
  h8 ks[KCH], vs[VCH];
  const int qpos = q0 + wid * 32 + r32;
  const int krow_ = (r32 & ~12) | ((r32 & 4) << 1) | ((r32 & 8) >> 1);
  const int kswz = ((krow_ >> 1) & 7) << 4;
  const int vb0 = (int)(uintptr_t)Vl + v_rd_base(lane);
  constexpr float THR = 8.f;
  float m_reg = 0.f, l_reg = 0.f;
  f32x16 negm;
#pragma unroll
  for (int r = 0; r < 16; ++r) negm[r] = 0.f;
#pragma unroll
  for (int d = 0; d < ND; ++d)
#pragma unroll
    for (int r = 0; r < 16; ++r) o[d][r] = 0.f;

#define TSTART(t) ((t) < nctx ? ctx_base + 64 * (t) : loc_base + 64 * ((t) - nctx))
#define SLOAD(t) do { const long kb_ = TSTART(t); _Pragma("unroll") for (int i = 0; i < KCH; ++i) ks[i] = *(const h8*)(Kp + kb_ * ldk + kgo[i]); \
    _Pragma("unroll") for (int i = 0; i < VCH; ++i) vs[i] = *(const h8*)(Vp + kb_ * ldv + vgo[i]); } while (0)
#define SWRITE(b, vbuf) do { _Pragma("unroll") for (int i = 0; i < KCH; ++i) *(h8*)(Kl + (b) * KB + klo[i]) = ks[i]; \
    _Pragma("unroll") for (int i = 0; i < VCH; ++i) *(h8*)(Vl + (vbuf) * 16384 + vlo[i]) = vs[i]; } while (0)
#define DO_PV(vb_) pv_tile<ND>(o, (vb_), pa0, pa1, pa2, pa3)

  h8 pa0, pa1, pa2, pa3;
  bool pact = false;
  int vcur = 0, vprev = 0;
  SLOAD(0); SWRITE(0, 0); __syncthreads();
  for (int t = 0; t < ntot; ++t) {
    const int cur = t & 1;
    const int vnext = vcur == 2 ? 0 : vcur + 1;
    if (t + 1 < ntot) SLOAD(t + 1);
    __builtin_amdgcn_sched_barrier(0);
    if (grp == 1 && pact) DO_PV(vb0 + vprev * 16384);
    bool active = true;
    int kr_ = 0, r_ = 0, c_ = 0, cs_ = 0;
    const int tstart = TSTART(t);
    if (MODE == 2 && t >= nctx) {
      kr_ = tstart >> 6; r_ = qpos >> 6; c_ = qpos & 63;
      int rs = r_ - 4; rs = rs < 0 ? 0 : (rs > 248 ? 248 : rs);
      cs_ = c_ - 8; cs_ = cs_ < 0 ? 0 : (cs_ > 48 ? 48 : cs_);
      active = (kr_ >= rs) && (kr_ < rs + 8);
    }
    bool need_mask = true;
    if (MODE == 1 && t >= nctx) {
      const int w0 = q0 + wid * 32;
      active = !((tstart + 63 < w0 - 128) || (tstart > w0 + 31 + 128));
      need_mask = !((tstart >= w0 + 31 - 128) && (tstart + 63 <= w0 + 128));
    }
    if (active) {
      f32x16 p0, p1;
      float alpha = 1.f, ps;
      constexpr bool SKIPMAX = (DV == 128 && MODE == 0);
      bool redo = !SKIPMAX || (t == 0);
      for (;;) {
      p0 = negm; p1 = negm;
      const char* Kc = Kl + cur * KB;
#pragma unroll
      for (int d0 = 0; d0 < DK / 16; ++d0) {
        const int cb = (d0 * 32 + hi * 16) ^ kswz;
        h8 b0 = *(const h8*)(Kc + krow_ * (DK * 2) + cb);
        h8 b1 = *(const h8*)(Kc + (32 + krow_) * (DK * 2) + cb);
        p0 = mfma16(b0, qr[d0], p0);
        p1 = mfma16(b1, qr[d0], p1);
        if (DK > 64 && (d0 & 3) == 3) __builtin_amdgcn_sched_barrier(0);
      }
      if (MODE == 1 && t >= nctx && need_mask) {
#pragma unroll
        for (int r = 0; r < 16; ++r) {
          const int kk_ = 16 * (r >> 3) + 8 * hi + (r & 7);
          int d0_ = qpos - (tstart + kk_); d0_ = d0_ < 0 ? -d0_ : d0_;
          int d1_ = qpos - (tstart + 32 + kk_); d1_ = d1_ < 0 ? -d1_ : d1_;
          p0[r] = d0_ <= 128 ? p0[r] : NEGV;
          p1[r] = d1_ <= 128 ? p1[r] : NEGV;
        }
      }
      if (MODE == 2 && t >= nctx) {
        const float* rb_ = rpb_h + (kr_ - r_ + 7) * 32;
        const int cb15 = 15 - c_;
#pragma unroll
        for (int r = 0; r < 16; ++r) {
          const int kc0 = 16 * (r >> 3) + 8 * hi + (r & 7), kc1 = 32 + kc0;
          const float b0 = rb_[(kc0 + cb15) & 31], b1 = rb_[(kc1 + cb15) & 31];
          p0[r] = ((unsigned)(kc0 - cs_) < 16u) ? p0[r] + b0 : NEGV;
          p1[r] = ((unsigned)(kc1 - cs_) < 16u) ? p1[r] + b1 : NEGV;
        }
      }
      if (redo) {
        float pm0 = fmaxf(p0[0], p0[1]), pm1 = fmaxf(p0[2], p0[3]), pm2 = fmaxf(p1[0], p1[1]), pm3 = fmaxf(p1[2], p1[3]);
#pragma unroll
        for (int r = 4; r < 16; r += 4) {
          pm0 = fmaxf(pm0, fmaxf(p0[r], p0[r + 1])); pm1 = fmaxf(pm1, fmaxf(p0[r + 2], p0[r + 3]));
          pm2 = fmaxf(pm2, fmaxf(p1[r], p1[r + 1])); pm3 = fmaxf(pm3, fmaxf(p1[r + 2], p1[r + 3]));
        }
        float pmax = fmaxf(fmaxf(pm0, pm1), fmaxf(pm2, pm3));
        { auto rr = __builtin_amdgcn_permlane32_swap(__float_as_uint(pmax), __float_as_uint(pmax), false, false);
          pmax = fmaxf(__uint_as_float(rr[0]), __uint_as_float(rr[1])); }
        if (SKIPMAX || t == 0 || __any(pmax > THR)) {
          const float delta = (t == 0) ? pmax : fmaxf(pmax, 0.f);
#pragma unroll
          for (int r = 0; r < 16; ++r) { p0[r] -= delta; p1[r] -= delta; }
          if (t != 0) alpha = __builtin_amdgcn_exp2f(-delta);
          m_reg += delta;
#pragma unroll
          for (int r = 0; r < 16; ++r) negm[r] = -m_reg;
        }
      }
      float ps0 = 0.f, ps1 = 0.f, ps2 = 0.f, ps3 = 0.f;
#pragma unroll
      for (int r = 0; r < 16; r += 2) {
        p0[r] = __builtin_amdgcn_exp2f(p0[r]); ps0 += p0[r]; p0[r + 1] = __builtin_amdgcn_exp2f(p0[r + 1]); ps1 += p0[r + 1];
        p1[r] = __builtin_amdgcn_exp2f(p1[r]); ps2 += p1[r]; p1[r + 1] = __builtin_amdgcn_exp2f(p1[r + 1]); ps3 += p1[r + 1];
      }
      ps = (ps0 + ps1) + (ps2 + ps3);
      { auto rr = __builtin_amdgcn_permlane32_swap(__float_as_uint(ps), __float_as_uint(ps), false, false);
        ps = __uint_as_float(rr[0]) + __uint_as_float(rr[1]); }
      if (!redo && __any(!(ps <= 16384.f))) { redo = true; continue; }
      break;
      }
      l_reg = l_reg * alpha + ps;
#define PK8(P, BASE, OUT) do { u32x4 w = {cvtpk(P[BASE + 0], P[BASE + 1]), cvtpk(P[BASE + 2], P[BASE + 3]), cvtpk(P[BASE + 4], P[BASE + 5]), cvtpk(P[BASE + 6], P[BASE + 7])}; \
    OUT = __builtin_bit_cast(h8, w); } while (0)
      PK8(p0, 0, pa0); PK8(p0, 8, pa1); PK8(p1, 0, pa2); PK8(p1, 8, pa3);
#undef PK8
      if (__any(alpha < 1.f)) {
        if (hi == 0) wsf[r32] = alpha;
        __builtin_amdgcn_wave_barrier();
        float al[16];
#pragma unroll
        for (int r = 0; r < 16; ++r) al[r] = wsf[crow(r, hi)];
#pragma unroll
        for (int d = 0; d < ND; ++d)
#pragma unroll
          for (int r = 0; r < 16; ++r) o[d][r] *= al[r];
        __builtin_amdgcn_wave_barrier();
      }
      if (grp == 0) DO_PV(vb0 + vcur * 16384);
    }
    pact = active;
    __builtin_amdgcn_sched_barrier(0);
    if (t + 1 < ntot) SWRITE(cur ^ 1, vnext);
    vprev = vcur; vcur = vnext;
    __syncthreads();
  }
  if (grp == 1 && pact) DO_PV(vb0 + vprev * 16384);
  __syncthreads();
#undef DO_PV
#undef SLOAD
#undef SWRITE
#undef TSTART
  l_out = l_reg; m_out = m_reg;
}

template <int DK, int DV>
DI void attn_core_pipe(const hf* __restrict__ Qp, int ldq, const hf* __restrict__ Kp, int ldk, const hf* __restrict__ Vp, int ldv,
                       int q0, int kbase, int ntot, f32x16 (&o)[DV / 32], float& l_out, float& m_out, char* lds) {
  int tid = threadIdx.x; asm volatile("" : "+v"(tid));
  const int wid = __builtin_amdgcn_readfirstlane(tid >> 6), lane = tid & 63, r32 = lane & 31, hi = lane >> 5;
  constexpr int KB = 64 * DK * 2, NKC = DK / 8, KCH = 64 * NKC / NTHR, NVC = DV / 8, VCH = 64 * NVC / NTHR;
  constexpr int ND = DV / 32;
  static_assert(3 * KB <= 49152, "K ring must fit its region");
  char* Vl = lds; char* Kl = lds + 49152; float* wsf = (float*)(lds + 98304) + wid * 64;
  h8 qr[DK / 16];
  {
    const hf* Qw = Qp + (long)(q0 + wid * 32 + r32) * ldq + hi * 8;
#pragma unroll
    for (int d0 = 0; d0 < DK / 16; ++d0) qr[d0] = *(const h8*)(Qw + d0 * 16);
  }
  int kgo[KCH], klo[KCH], vgo[VCH], vlo[VCH];
#pragma unroll
  for (int i = 0; i < KCH; ++i) { int c = tid + NTHR * i, row = c / NKC, ch = c % NKC; kgo[i] = row * ldk + ch * 8; klo[i] = row * (DK * 2) + ((ch * 16) ^ (((row >> 1) & 7) << 4)); }
#pragma unroll
  for (int i = 0; i < VCH; ++i) { int c = tid + NTHR * i, row = c / NVC, ch = c % NVC; vgo[i] = row * ldv + ch * 8; vlo[i] = v_st(row, ch * 8); }
  h8 ks[KCH], vs[VCH];
  const int kswz = ((r32 >> 1) & 7) << 4;
  const int vb0 = (int)(uintptr_t)Vl + v_rd_base(lane);
  float m_reg = NEGV, l_reg = 0.f;
#pragma unroll
  for (int d = 0; d < ND; ++d)
#pragma unroll
    for (int r = 0; r < 16; ++r) o[d][r] = 0.f;
  const int tlast = ntot - 1;
#define KLOAD(t) do { const int tt_ = (t) < tlast ? (t) : tlast; const long kb_ = kbase + 64 * tt_; _Pragma("unroll") for (int i = 0; i < KCH; ++i) ks[i] = *(const h8*)(Kp + kb_ * ldk + kgo[i]); } while (0)
#define VLOAD(t) do { const int tt_ = (t) < tlast ? (t) : tlast; const long kb_ = kbase + 64 * tt_; _Pragma("unroll") for (int i = 0; i < VCH; ++i) vs[i] = *(const h8*)(Vp + kb_ * ldv + vgo[i]); } while (0)
#define KWRITE(slot) do { _Pragma("unroll") for (int i = 0; i < KCH; ++i) *(h8*)(Kl + (slot) * KB + klo[i]) = ks[i]; } while (0)
#define VWRITE(b) do { _Pragma("unroll") for (int i = 0; i < VCH; ++i) *(h8*)(Vl + (b) * 16384 + vlo[i]) = vs[i]; } while (0)
#define QKT(S0, S1, slot) do { const char* Kc_ = Kl + (slot) * KB; \
    _Pragma("unroll") for (int r = 0; r < 16; ++r) { S0[r] = 0.f; S1[r] = 0.f; } \
    _Pragma("unroll") for (int d0 = 0; d0 < DK / 16; ++d0) { const int cb_ = (d0 * 32 + hi * 16) ^ kswz; \
      h8 b0_ = *(const h8*)(Kc_ + r32 * (DK * 2) + cb_); h8 b1_ = *(const h8*)(Kc_ + (32 + r32) * (DK * 2) + cb_); \
      S0 = mfma16(b0_, qr[d0], S0); S1 = mfma16(b1_, qr[d0], S1); } } while (0)
#define PK4(P, BASE, OUT) do { unsigned a0 = cvtpk(P[BASE + 0], P[BASE + 1]), a1 = cvtpk(P[BASE + 2], P[BASE + 3]);   \
    unsigned b0 = cvtpk(P[BASE + 4], P[BASE + 5]), b1 = cvtpk(P[BASE + 6], P[BASE + 7]);                              \
    auto r0 = __builtin_amdgcn_permlane32_swap(a0, b0, false, false); auto r1 = __builtin_amdgcn_permlane32_swap(a1, b1, false, false); \
    u32x4 w = {r0[0], r1[0], r0[1], r1[1]}; OUT = __builtin_bit_cast(h8, w); } while (0)
#define STEP(C0, C1, N0, N1, t) do { \
    KLOAD((t) + 2); VLOAD((t) + 1); \
    __builtin_amdgcn_sched_barrier(0); \
    QKT(N0, N1, s1); \
    float pm0 = fmaxf(C0[0], C0[1]), pm1 = fmaxf(C0[2], C0[3]), pm2 = fmaxf(C1[0], C1[1]), pm3 = fmaxf(C1[2], C1[3]); \
    _Pragma("unroll") for (int r = 4; r < 16; r += 4) { \
      pm0 = fmaxf(pm0, fmaxf(C0[r], C0[r + 1])); pm1 = fmaxf(pm1, fmaxf(C0[r + 2], C0[r + 3])); \
      pm2 = fmaxf(pm2, fmaxf(C1[r], C1[r + 1])); pm3 = fmaxf(pm3, fmaxf(C1[r + 2], C1[r + 3])); } \
    float pmax = fmaxf(fmaxf(pm0, pm1), fmaxf(pm2, pm3)); \
    { auto rr = __builtin_amdgcn_permlane32_swap(__float_as_uint(pmax), __float_as_uint(pmax), false, false); \
      pmax = fmaxf(__uint_as_float(rr[0]), __uint_as_float(rr[1])); } \
    const float mn = fmaxf(m_reg, pmax); \
    const float alpha = __builtin_amdgcn_exp2f(m_reg - mn); \
    m_reg = mn; \
    float ps, ps0 = 0.f, ps1 = 0.f, ps2 = 0.f, ps3 = 0.f; \
    _Pragma("unroll") for (int r = 0; r < 16; r += 2) { \
      C0[r] = __builtin_amdgcn_exp2f(C0[r] - mn); ps0 += C0[r]; C0[r + 1] = __builtin_amdgcn_exp2f(C0[r + 1] - mn); ps1 += C0[r + 1]; \
      C1[r] = __builtin_amdgcn_exp2f(C1[r] - mn); ps2 += C1[r]; C1[r + 1] = __builtin_amdgcn_exp2f(C1[r + 1] - mn); ps3 += C1[r + 1]; } \
    ps = (ps0 + ps1) + (ps2 + ps3); \
    { auto rr = __builtin_amdgcn_permlane32_swap(__float_as_uint(ps), __float_as_uint(ps), false, false); \
      ps = __uint_as_float(rr[0]) + __uint_as_float(rr[1]); } \
    l_reg = l_reg * alpha + ps; \
    h8 pa0, pa1, pa2, pa3; \
    PK4(C0, 0, pa0); PK4(C0, 8, pa1); PK4(C1, 0, pa2); PK4(C1, 8, pa3); \
    if (__any(alpha < 1.f)) { \
      if (hi == 0) wsf[r32] = alpha; \
      __builtin_amdgcn_wave_barrier(); \
      float al[16]; \
      _Pragma("unroll") for (int r = 0; r < 16; ++r) al[r] = wsf[crow(r, hi)]; \
      _Pragma("unroll") for (int d = 0; d < ND; ++d) _Pragma("unroll") for (int r = 0; r < 16; ++r) o[d][r] *= al[r]; \
      __builtin_amdgcn_wave_barrier(); \
    } \
    pv_tile<ND>(o, vb0 + ((t) & 1) * 16384, pa0, pa1, pa2, pa3); \
    KWRITE(s2); VWRITE(((t) + 1) & 1); \
    { const int s3 = 3 - s1 - s2; s1 = s2; s2 = s3; } \
    __syncthreads(); \
  } while (0)

  f32x16 pA0, pA1, pB0, pB1;
  KLOAD(0); VLOAD(0); KWRITE(0); VWRITE(0); KLOAD(1); KWRITE(1);
  __syncthreads();
  QKT(pA0, pA1, 0);
  int s1 = 1, s2 = 2;
  for (int t = 0; t < ntot; t += 2) {
    STEP(pA0, pA1, pB0, pB1, t);
    STEP(pB0, pB1, pA0, pA1, t + 1);
  }
#undef STEP
#undef PK4
#undef QKT
#undef KLOAD
#undef VLOAD
#undef KWRITE
#undef VWRITE
  l_out = l_reg; m_out = m_reg;
}

DI void row_bcast(float val, float (&out)[16], char* lds) {
  const int tid = threadIdx.x, wid = tid >> 6, lane = tid & 63, r32 = lane & 31, hi = lane >> 5;
  float* wsf = (float*)(lds + 98304) + wid * 64 + 32;
  __builtin_amdgcn_wave_barrier();
  if (hi == 0) wsf[r32] = val;
  __builtin_amdgcn_wave_barrier();
#pragma unroll
  for (int r = 0; r < 16; ++r) out[r] = wsf[crow(r, hi)];
  __builtin_amdgcn_wave_barrier();
}

template <int ND>
DI void store_y(const Params& p, f32x16 (&o)[ND], float l, int q0, int ycol, const hf* SG, int ldsg, int sgcol, char* lds) {
  int tid = threadIdx.x; asm volatile("" : "+v"(tid));
  const int wid = tid >> 6, lane = tid & 63, r32 = lane & 31, hi = lane >> 5;
  float rl[16];
  row_bcast(1.f / l, rl, lds);
  constexpr int G = 16 / ND;
#pragma unroll
  for (int r0 = 0; r0 < 16; r0 += G) {
    hf sgv[G][ND];
#pragma unroll
    for (int g = 0; g < G; ++g) {
      const long row = q0 + wid * 32 + crow(r0 + g, hi);
#pragma unroll
      for (int d = 0; d < ND; ++d) sgv[g][d] = SG[row * ldsg + sgcol + d * 32 + r32];
    }
    __builtin_amdgcn_sched_barrier(0);
#pragma unroll
    for (int g = 0; g < G; ++g) {
      const long row = q0 + wid * 32 + crow(r0 + g, hi);
#pragma unroll
      for (int d = 0; d < ND; ++d) p.Y[row * DM + ycol + d * 32 + r32] = (hf)(o[d][r0 + g] * rl[r0 + g] * (float)sgv[g][d]);
    }
    __builtin_amdgcn_sched_barrier(0);
  }
}

DI void phase_attn_even(const Params& p, char* lds) {
  const int tid = threadIdx.x, wid = tid >> 6, lane = tid & 63, r32 = lane & 31, hi = lane >> 5;
  const hf* PE = p.P;
  float* O1 = (float*)p.H;
  constexpr int NB = 256, NBC = 4, NA = 512, NAC = 8, NIT = NB + NBC + NA + NAC;
  const float lam = p.lam[0];
  for (int it = blockIdx.x; it < NIT; it += gridDim.x) {
    if (it < NB + NBC) {
      int hb, q0, nctx, ntot;
      if (it < NB) { hb = it >> 6; q0 = (it & 63) * 256; nctx = 0; ntot = M_ALL / 64; }
      else { hb = it - NB; q0 = S_LAT; nctx = 4; ntot = 4; }
      f32x16 o[4]; float l, m;
      attn_core<64, 128, 0>(PE + 768 + (hb * 2) * 64, IN_E, PE + 1280 + (hb * 2) * 64, IN_E, PE + 1792 + hb * 128, IN_E,
                            q0, nctx, S_LAT, 0, ntot, nullptr, o, l, m, lds);
      {
        float rl[16]; row_bcast(1.f / l, rl, lds);
#pragma unroll
        for (int r = 0; r < 16; ++r) {
          const long row = q0 + wid * 32 + crow(r, hi);
#pragma unroll
          for (int d = 0; d < 4; ++d) O1[row * 512 + hb * 128 + d * 32 + r32] = o[d][r] * rl[r];
          __builtin_amdgcn_sched_barrier(0);
        }
      }
      attn_core<64, 128, 0>(PE + 768 + (hb * 2 + 1) * 64, IN_E, PE + 1280 + (hb * 2 + 1) * 64, IN_E, PE + 1792 + hb * 128, IN_E,
                            q0, nctx, S_LAT, 0, ntot, nullptr, o, l, m, lds);
      {
        float rl[16]; row_bcast(1.f / l, rl, lds);
#pragma unroll
        for (int r = 0; r < 16; ++r) {
          const long row = q0 + wid * 32 + crow(r, hi);
          float ss = 0.f;
#pragma unroll
          for (int d = 0; d < 4; ++d) {
            const float v = O1[row * 512 + hb * 128 + d * 32 + r32] - lam * (o[d][r] * rl[r]);
            o[d][r] = v; ss += v * v;
          }
#pragma unroll
          for (int s = 16; s >= 1; s >>= 1) ss += __shfl_xor(ss, s);
          const float rstd = rsqrtf(ss * (1.f / 128.f) + EPS) * 0.8f;
#pragma unroll
          for (int d = 0; d < 4; ++d) {
            const int cc = hb * 128 + d * 32 + r32;
            const float sg = (float)PE[row * IN_E + 2304 + 512 + cc];
            p.Y[row * DM + 512 + cc] = (hf)(o[d][r] * rstd * p.ev_b_subln_g[d * 32 + r32] * sg);
          }
          __builtin_amdgcn_sched_barrier(0);
        }
      }
    } else {
      int ia = it - NB - NBC, h, q0, lb, ntot;
      if (ia < NA) {
        h = ia >> 6; q0 = (ia & 63) * 256;
        lb = q0 - 128 < 0 ? 0 : q0 - 128;
        int le = q0 + 384 > S_LAT ? S_LAT : q0 + 384;
        ntot = 4 + (le - lb) / 64;
      } else { h = ia - NA; q0 = S_LAT; lb = 0; ntot = 4; }
      f32x16 o[2]; float l, m;
      attn_core<64, 64, 1>(PE + h * 64, IN_E, PE + 512 + (h >> 2) * 64, IN_E, PE + 640 + (h >> 2) * 64, IN_E,
                           q0, 4, S_LAT, lb, ntot, nullptr, o, l, m, lds);
      l += __builtin_amdgcn_exp2f(p.ev_a_sink[h] * LOG2E - m);
      store_y<2>(p, o, l, q0, h * 64, PE, IN_E, 2304 + h * 64, lds);
    }
  }
}

DI void phase_attn_odd(const Params& p, char* lds) {
  const hf* PO = p.P; const hf* VC = p.H + (long)M_ALL * 384;
  constexpr int NC = 256, ND_ = 512;
  for (int it = blockIdx.x; it < NC + ND_; it += gridDim.x) {
    if (it < NC) {
      const int h = it >> 6, q0 = (it & 63) * 256;
      f32x16 o[4]; float l, m;
      attn_core<192, 128, 0>(p.QC + h * 192, 768, p.KC + h * 192, 768, VC + h * 128, 512, q0, 0, S_LAT, 0, M_ALL / 64, nullptr, o, l, m, lds);
      store_y<4>(p, o, l, q0, h * 128, PO, IN_OP, 1984 + h * 128, lds);
    } else {
      const int id = it - NC, h = id >> 6, q0 = (id & 63) * 256, R0 = q0 >> 6;
      int lo_r = R0 - 4; lo_r = lo_r < 0 ? 0 : (lo_r > 248 ? 248 : lo_r);
      int hi_r = R0 - 1; hi_r = hi_r < 0 ? 0 : (hi_r > 248 ? 248 : hi_r); hi_r += 7;
      f32x16 o[2]; float l, m;
      attn_core<64, 64, 2>(PO + 448 + h * 64, IN_OP, PO + 960 + h * 64, IN_OP, PO + 1472 + h * 64, IN_OP,
                           q0, 4, S_LAT, lo_r * 64, 4 + (hi_r - lo_r + 1), p.rpb2 + h * 480, o, l, m, lds);
      store_y<2>(p, o, l, q0, 512 + h * 64, PO, IN_OP, 1984 + 512 + h * 64, lds);
    }
  }
}

#define XB_TMO      128
#define XB_XCNT(j)  (256  + 64 * (j))
#define XB_XSUB(j)  (1280 + 64 * (j))
#define XB_XGEN(j)  (2304 + 64 * (j))
#define XB_TOP      3328
#define XB_TOPGEN   3392
#define XCD_BAR_WORDS 3456
#define XB_SPIN_CAP (1u << 22)
DI unsigned xb_ld(unsigned* p) { return __hip_atomic_load(p, __ATOMIC_RELAXED, __HIP_MEMORY_SCOPE_AGENT); }
DI unsigned xb_add(unsigned* p, unsigned v) { return __hip_atomic_fetch_add(p, v, __ATOMIC_RELAXED, __HIP_MEMORY_SCOPE_AGENT); }
DI unsigned xb_xcc_id() { return (unsigned)__builtin_amdgcn_s_getreg((3 << 11) | 20) & 0xFu; }
#define XB_SPIN(cond, bar) do { unsigned _sp = 0; while (cond) { __builtin_amdgcn_s_sleep(1); \
    if ((++_sp & 255u) == 0u) { if (xb_ld(&(bar)[XB_TMO])) break; if (_sp > XB_SPIN_CAP) { atomicAdd(&(bar)[XB_TMO], 1u); break; } } } } while (0)
DI void xcd_barrier_complete(unsigned* bar, unsigned x, unsigned& nloc, unsigned& nx) {
  const unsigned G = gridDim.x;
  unsigned sum, cnt, mine, sp = 0u;
  for (;;) {
    sum = 0u; cnt = 0u; mine = 0u;
#pragma unroll
    for (unsigned j = 0; j < 16; ++j) { const unsigned c = xb_ld(&bar[XB_XCNT(j)]); sum += c; cnt += (c > 0u) ? 1u : 0u; mine = (j == x) ? c : mine; }
    if (sum == G) break;
    __builtin_amdgcn_s_sleep(1);
    if ((++sp & 255u) == 0u) { if (xb_ld(&bar[XB_TMO])) break; if (sp > XB_SPIN_CAP) { atomicAdd(&bar[XB_TMO], 1u); break; } }
  }
  nloc = mine > 0u ? mine : 1u; nx = cnt > 0u ? cnt : 1u;
}
DI void grid_bar(unsigned* bar, unsigned x, volatile unsigned* st) {
  asm volatile("s_waitcnt vmcnt(0)" ::: "memory");
  __syncthreads();
  if (threadIdx.x == 0) {
    __builtin_amdgcn_s_waitcnt(0);
    unsigned nloc = st[0], nx = st[1];
    if (nloc == 0u) { xcd_barrier_complete(bar, x, nloc, nx); st[0] = nloc; st[1] = nx; }
    const unsigned old = xb_add(&bar[XB_XSUB(x)], 1u);
    const unsigned gen = old / nloc;
    if (old + 1u == (gen + 1u) * nloc) {
      __builtin_amdgcn_fence(__ATOMIC_RELEASE, "agent");
      asm volatile("s_waitcnt vmcnt(0)" ::: "memory");
      const unsigned og = xb_add(&bar[XB_TOP], 1u);
      const unsigned tg = og / nx;
      if (og + 1u == (tg + 1u) * nx) xb_add(&bar[XB_TOPGEN], 1u);
      else XB_SPIN(xb_ld(&bar[XB_TOPGEN]) == tg, bar);
      __builtin_amdgcn_fence(__ATOMIC_ACQUIRE, "agent");
      xb_add(&bar[XB_XGEN(x)], 1u);
      asm volatile("s_waitcnt vmcnt(0)" ::: "memory");
    } else {
      XB_SPIN(xb_ld(&bar[XB_XGEN(x)]) == gen, bar);
      __builtin_amdgcn_fence(__ATOMIC_ACQUIRE, "agent");
      asm volatile("s_waitcnt vmcnt(0)" ::: "memory");
    }
  }
  __syncthreads();
}

__global__ void __launch_bounds__(NTHR) fwd_megakernel(Params p) {
  __shared__ __attribute__((aligned(16))) char lds[LDS_BYTES];
  __shared__ __attribute__((aligned(16))) unsigned xb_st[4];
  cg::grid_group grid = cg::this_grid();
  if (threadIdx.x < 4) xb_st[threadIdx.x] = 0u;
  const unsigned xcc = xb_xcc_id();
  if (threadIdx.x == 0) (void)xb_add(&p.bar[XB_XCNT(xcc)], 1u);
  __syncthreads();
  phase_prep(p, lds);            grid_bar(p.bar, xcc, xb_st);
  if (__builtin_expect(p.bar == nullptr, 0)) grid.sync();
  phase_modnorm(p, 0);           grid_bar(p.bar, xcc, xb_st);
  phase_inproj_even(p, lds);     grid_bar(p.bar, xcc, xb_st);
  phase_attn_even(p, lds);       grid_bar(p.bar, xcc, xb_st);
  phase_outproj(p, 0, lds);      grid_bar(p.bar, xcc, xb_st);
  phase_modnorm(p, 1);           grid_bar(p.bar, xcc, xb_st);
  phase_inproj_odd(p, lds);      grid_bar(p.bar, xcc, xb_st);
  phase_mla_rows(p);             grid_bar(p.bar, xcc, xb_st);
  phase_mla_proj(p, lds);        grid_bar(p.bar, xcc, xb_st);
  phase_attn_odd(p, lds);        grid_bar(p.bar, xcc, xb_st);
  phase_outproj(p, 1, lds);      grid_bar(p.bar, xcc, xb_st);
  phase_final(p);
}

extern "C" void kernel_launch(void* const* d_in, const int* in_sizes, int n_in, void* d_out, int out_size, void* d_ws, size_t ws_size, hipStream_t stream) {
  static int grid_blocks = 0;
  if (!grid_blocks) {
    int dev = 0, cus = 0, per_cu = 0;
    hipGetDevice(&dev);
    hipDeviceGetAttribute(&cus, hipDeviceAttributeMultiprocessorCount, dev);
    hipOccupancyMaxActiveBlocksPerMultiprocessor(&per_cu, fwd_megakernel, NTHR, 0);
    if (per_cu < 1) per_cu = 1;
    if (per_cu > 1) per_cu = 1;
    grid_blocks = cus * per_cu;
  }
  Params p{};
  const float* const* in = (const float* const*)d_in;
  p.x = in[0]; p.c = in[1]; p.ctx = in[2]; p.c_ctx = in[3]; p.ev_norm_g = in[4]; p.ev_w_ada = in[5]; p.ev_b_ada = in[6]; p.ev_w_in = in[7];
  p.ev_a_sink = in[8]; p.ev_b_lambda = in[9]; p.ev_b_subln_g = in[10]; p.ev_w_out = in[11];
  p.od_norm_g = in[12]; p.od_w_ada = in[13]; p.od_b_ada = in[14]; p.od_w_in = in[15]; p.od_q_norm_g = in[16]; p.od_kv_norm_g = in[17];
  p.od_w_qb = in[18]; p.od_w_kvb = in[19]; p.od_rpb = in[20]; p.od_w_out = in[21]; p.final_g = in[22];
  p.out = (float*)d_out;
  char* w = (char*)d_ws; size_t off = 0;
  auto take = [&](size_t bytes) { char* r = w + off; off += (bytes + 255) & ~(size_t)255; return r; };
  p.WinE = (hf*)take((size_t)IN_E * DM * 2); p.WinO = (hf*)take((size_t)IN_OP * DM * 2);
  p.WoutE = (hf*)take((size_t)DM * DM * 2); p.WoutO = (hf*)take((size_t)DM * DM * 2);
  p.Wqb = (hf*)take((size_t)768 * 256 * 2); p.Wkvb = (hf*)take((size_t)1024 * 128 * 2);
  p.mod = (float*)take(4 * 3072 * 4); p.rope = (float*)take(10240 * 4); p.lam = (float*)take(256); p.rpb2 = (float*)take(8 * 15 * 32 * 4);
  p.H = (hf*)take((size_t)M_ALL * DM * 2);
  p.P = (hf*)take((size_t)M_ALL * IN_E * 2);
  p.Y = (hf*)take((size_t)M_ALL * DM * 2);
  p.QC = (hf*)take((size_t)M_ALL * 768 * 2); p.KC = (hf*)take((size_t)M_ALL * 768 * 2);
  p.x1ctx = (float*)take((size_t)256 * DM * 4);
  p.bar = (unsigned*)take(XCD_BAR_WORDS * 4);
  if (off > ws_size) { fprintf(stderr, "kernel_launch: workspace too small (%zu > %zu)\n", off, ws_size); return; }
  hipMemsetAsync(p.bar, 0, XCD_BAR_WORDS * 4, stream);
  void* args[] = {&p};
  hipError_t e = hipLaunchCooperativeKernel((void*)fwd_megakernel, dim3(grid_blocks), dim3(NTHR), args, 0, stream);
  if (e != hipSuccess) fprintf(stderr, "cooperative launch failed: %s (grid %d)\n", hipGetErrorString(e), grid_blocks);
}
```
